# Optimizing an MI355X kernel written in HIP

```python
import jax, jax.numpy as jnp
from jax import lax
import numpy as np

D_MODEL = 2048
BATCH = 2
SEQ = 8192
DEPTH = 4

CHUNK = 64
EPS = 1e-6
MIN_FORGET = 1e-30
A_VAL = 128
A_KEY = 128
A_VW = D_MODEL // 2
A_HEADS = A_VW // A_VAL
A_KW = A_HEADS * A_KEY
B_WIDTH = D_MODEL // 2
B_WINDOWS = (2, 4, 8, 16)
B_GROUPS = len(B_WINDOWS)
B_GW = B_WIDTH // B_GROUPS
IN_SIZES = (A_KW, A_KW, A_VW, A_VW, B_WIDTH, B_WIDTH, D_MODEL, D_MODEL)
IN_COLS = sum(IN_SIZES)
IN_SPLITS = [int(v) for v in np.cumsum(IN_SIZES)[:-1]]

kernel_name = "hybrid_hgrn2_pool_gated_trunk"


def rmsnorm(x, gain):
    xf = x.astype(jnp.float32)
    y = xf * lax.rsqrt(jnp.mean(xf * xf, axis=-1, keepdims=True) + EPS)
    return y.astype(x.dtype) * gain


def hgrn2_mixer(q_raw, f_raw, v, lb):
    f32 = jnp.float32
    bsz, seq, _ = q_raw.shape
    nc = seq // CHUNK
    q = jax.nn.silu(q_raw.astype(f32))
    a = f_raw.astype(f32)
    lb = lb.astype(f32)
    f = lb + (1.0 - lb) * jax.nn.sigmoid(a)
    log_f = jnp.log(jnp.maximum(f, MIN_FORGET))
    k = (1.0 - lb) * jax.nn.sigmoid(-a)
    v = v.astype(f32)

    def to_chunks(t, d):
        return t.reshape(bsz, nc, CHUNK, A_HEADS, d).transpose(1, 0, 3, 2, 4)

    qc, kc, lfc = to_chunks(q, A_KEY), to_chunks(k, A_KEY), to_chunks(log_f, A_KEY)
    vc = to_chunks(v, A_VAL)
    causal = jnp.tril(jnp.ones((CHUNK, CHUNK), dtype=bool))[:, :, None]
    causal_f = causal.astype(f32)

    def step(state, inp):
        qi, ki, vi, lfi = inp
        b = jnp.cumsum(lfi, axis=2)
        o_inter = jnp.einsum('bhtk,bhkv->bhtv', qi * jnp.exp(b), state)
        diff = b[:, :, :, None, :] - b[:, :, None, :, :]
        decay = jnp.exp(jnp.where(causal, diff, 0.0)) * causal_f
        scores = jnp.einsum('bhtk,bhtsk,bhsk->bhts', qi, decay, ki)
        o = o_inter + jnp.einsum('bhts,bhsv->bhtv', scores, vi)
        b_last = b[:, :, -1:, :]
        state = (jnp.exp(b_last[:, :, 0, :])[..., None] * state
                 + jnp.einsum('bhsk,bhsv->bhkv', ki * jnp.exp(b_last - b), vi))
        return state, o

    state0 = jnp.zeros((bsz, A_HEADS, A_KEY, A_VAL), f32)
    _, o = lax.scan(step, state0, (qc, kc, vc, lfc))
    return o.transpose(1, 0, 3, 2, 4).reshape(bsz, seq, A_HEADS, A_VAL)


def pool_mixer(v, pool_w, pool_scale):
    f32 = jnp.float32
    bsz, seq, _ = v.shape
    vf = v.astype(f32)
    cs = jnp.concatenate([jnp.zeros((bsz, 1, B_WIDTH), f32), lax.cumsum(vf, axis=1)], axis=1)
    pos = jnp.arange(1, seq + 1, dtype=f32)[None, :, None]
    outs = []
    for g, w in enumerate(B_WINDOWS):
        sl = slice(g * B_GW, (g + 1) * B_GW)
        cs_g = cs[:, :, sl]
        shifted = jnp.pad(cs_g, ((0, 0), (w, 0), (0, 0)))[:, :seq + 1]
        mean = (cs_g - shifted)[:, 1:] / jnp.minimum(pos, float(w))
        outs.append(mean - vf[:, :, sl])
    pooled = jnp.stack(outs, axis=2)
    mixed = jnp.einsum('bsgc,gcd->bsgd', pooled, pool_w.astype(f32)).reshape(bsz, seq, B_WIDTH)
    return (mixed * pool_scale.astype(f32)).astype(v.dtype)


def setup_inputs(seed: int = 0) -> dict:
    key = jax.random.key(seed)
    ks = jax.random.split(key, 16)
    nrm = jax.random.normal
    f32 = jnp.float32
    return {
        "x": nrm(ks[0], (BATCH, SEQ, D_MODEL), f32),
        "c": nrm(ks[1], (BATCH, D_MODEL), f32),
        "w_ada": nrm(ks[2], (DEPTH, D_MODEL, 3 * D_MODEL), f32) * (0.5 * D_MODEL ** -0.5),
        "b_ada": nrm(ks[3], (DEPTH, 3 * D_MODEL), f32) * 0.02,
        "norm_pre": 1.0 + 0.1 * nrm(ks[4], (DEPTH, D_MODEL), f32),
        "norm_post": 1.0 + 0.1 * nrm(ks[5], (DEPTH, D_MODEL), f32),
        "w_in": nrm(ks[6], (DEPTH, D_MODEL, IN_COLS), f32) * D_MODEL ** -0.5,
        "lower_bounds": nrm(ks[7], (DEPTH, A_KW), f32),
        "hgrn_norm": 1.0 + 0.1 * nrm(ks[8], (DEPTH, A_VW), f32),
        "pool_w": nrm(ks[9], (DEPTH, B_GROUPS, B_GW, B_GW), f32) * B_GW ** -0.5,
        "pool_scale": 1.0 + 0.1 * nrm(ks[10], (DEPTH, B_WIDTH), f32),
        "w_proj_a": nrm(ks[11], (DEPTH, A_VW, D_MODEL), f32) * A_VW ** -0.5,
        "w_proj_b": nrm(ks[12], (DEPTH, B_WIDTH, D_MODEL), f32) * B_WIDTH ** -0.5,
        "w_out": nrm(ks[13], (DEPTH, D_MODEL, D_MODEL), f32) * D_MODEL ** -0.5,
    }


def reference(x, c, w_ada, b_ada, norm_pre, norm_post, w_in, lower_bounds, hgrn_norm,
              pool_w, pool_scale, w_proj_a, w_proj_b, w_out):
    bsz, seq, _ = x.shape
    sm = jax.nn.softmax(lower_bounds.astype(jnp.float32), axis=0)
    lb_all = jnp.cumsum(sm, axis=0) - sm[0:1]
    c_act = jax.nn.silu(c)
    for l in range(DEPTH):
        mod = c_act @ w_ada[l] + b_ada[l]
        shift, scale, gate = jnp.split(mod, 3, axis=-1)
        h = rmsnorm(x, norm_pre[l]) * (1.0 + scale[:, None, :]) + shift[:, None, :]
        proj = h @ w_in[l]
        q_a, f_a, v_a, z_a, v_b, z_b, g_a, g_b = jnp.split(proj, IN_SPLITS, axis=-1)
        o_a = hgrn2_mixer(q_a, f_a, v_a, lb_all[l])
        o_a = o_a * lax.rsqrt(jnp.mean(o_a * o_a, axis=-1, keepdims=True) + EPS)
        y_a = o_a.reshape(bsz, seq, A_VW).astype(x.dtype) * hgrn_norm[l] * jax.nn.silu(z_a)
        y_b = pool_mixer(v_b, pool_w[l], pool_scale[l]) * jax.nn.silu(z_b)
        merged = jax.nn.sigmoid(g_a) * (y_a @ w_proj_a[l]) + jax.nn.sigmoid(g_b) * (y_b @ w_proj_b[l])
        out = merged @ w_out[l]
        x = x + gate[:, None, :] * rmsnorm(out, norm_post[l])
    return x
```

```cpp
#include <hip/hip_runtime.h>
#include <hip/hip_cooperative_groups.h>
#include <cstdio>
#include <cstdint>
namespace cg = cooperative_groups;
namespace pg8 {
#define PG8_LAS __attribute__((address_space(3)))
typedef unsigned short bf16_t;
typedef short bf16x8 __attribute__((ext_vector_type(8)));
typedef float f32x4 __attribute__((ext_vector_type(4)));
typedef unsigned u32x4 __attribute__((ext_vector_type(4)));
constexpr int BM = 256, BK = 64, HALF = 128, HTB = HALF * BK * 2  , STAGE_BYTES = 8 * HTB, NXCD = 8, WGM = 8;

__host__ __device__ __forceinline__ int lds_byte(int r, int c) { const int st = (r >> 4) * 2 + (c >> 5), rr = r & 15, cc = c & 31, ob = rr * 64 + cc * 2; return st * 1024 + (ob ^ (((ob >> 9) & 1) << 5)); }
__host__ __device__ __forceinline__ void stage_rc(int b, int& R, int& C) { const int st = b / 1024, sb = b % 1024, swz = sb ^ (((sb >> 9) & 1) << 5); R = (st >> 1) * 16 + swz / 64; C = (st & 1) * 32 + (swz % 64) / 2; }
__host__ __device__ __forceinline__ int perm32(int rho) { const int n = rho >> 4, i = rho & 15; return 8 * (i >> 2) + 4 * n + (i & 3); }

struct Unit { int pm, pn; };
struct Gemm { const bf16_t* A; const bf16_t* Bt; int M, N, K, lda, ldb, akoff; };

struct StaticOrder {
    int nM, nN, nwg, G, c;
    __host__ __device__ void init(int M, int N, int G_, int c_) { nM = M / BM; nN = N / BM; nwg = nM * nN; G = G_; c = c_; }
    __host__ __device__ bool next(int i, Unit& u) const {
        const long L = (long)i * G + c; if (L >= nwg) return false;
        int wgid = (int)L; { const int q = nwg / NXCD, r = nwg % NXCD, xcd = wgid % NXCD, off = wgid / NXCD; wgid = (xcd < r ? xcd * (q + 1) : r * (q + 1) + (xcd - r) * q) + off; }
        const int nig = WGM * nN, gid = wgid / nig, fm = gid * WGM, gsz = (nM - fm) < WGM ? (nM - fm) : WGM;
        u.pm = fm + ((wgid % nig) % gsz); u.pn = (wgid % nig) / gsz; return true;
    }
    __device__ __forceinline__ void a_ready(const Unit&) const {}
    __device__ __forceinline__ void done(const Unit&) const {}
};
__device__ __forceinline__ unsigned cvt_pk_bf16(float lo, float hi) { unsigned r; asm volatile("v_cvt_pk_bf16_f32 %0, %1, %2" : "=v"(r) : "v"(lo), "v"(hi)); return r; }
template <class Epi, class Sched, bool ALIGN_EPI = false, bool SP2 = false>
__device__ __forceinline__ void gemm_phase(PG8_LAS unsigned char* lds, const Gemm g, const Sched& S, const Epi& E) {
    int tid_ = threadIdx.x; asm volatile("" : "+v"(tid_));
    const int tid = tid_, wid = __builtin_amdgcn_readfirstlane(tid >> 6), lane = tid & 63, wr = wid >> 2, wc = wid & 3, fr = lane & 15, fq = lane >> 4;
    const int K = g.K, nt = K / BK;
    unsigned voffA[2], voffB[2];
#pragma unroll
    for (int i = 0; i < 2; ++i) { int R, C; stage_rc(tid * 16 + i * 8192, R, C); const int Rb = Epi::PERM ? ((R & ~31) + perm32(R & 31)) : R;
        voffA[i] = (unsigned)(R * g.lda + C) * 2u; voffB[i] = (unsigned)(Rb * g.ldb + C) * 2u; }
    const size_t kstep = (size_t)(BK * 2);
    const size_t hstepA = (size_t)HALF * g.lda * 2, hstepB = (size_t)HALF * g.ldb * 2;
    const size_t tstepA = 2 * hstepA, tstepB = 2 * hstepB, akb = (size_t)g.akoff * 2;
    const unsigned ldsw = (unsigned)wid * 1024u;
    const int aoff = lds_byte(wr * 64 + fr, fq * 8), boff = lds_byte(wc * 32 + fr, fq * 8);
#define PG8_SA(b, h) (((b) * 2 + (h)) * HTB)
#define PG8_SB(b, h) ((4 + (b) * 2 + (h)) * HTB)
#define PG8_STAGE(bufoff, gbase, voff) do { _Pragma("unroll") for (int _i = 0; _i < 2; ++_i) \
        __builtin_amdgcn_global_load_lds((const unsigned*)((const char*)(gbase) + (voff)[_i]), (PG8_LAS unsigned*)(lds + (bufoff) + ldsw + _i * 8192), 16, 0, 0); } while (0)
#define PG8_LDA(dst, b, h) do { _Pragma("unroll") for (int m = 0; m < 4; ++m) _Pragma("unroll") for (int k = 0; k < 2; ++k) dst[m][k] = *(const PG8_LAS bf16x8*)(lds + PG8_SA(b, h) + aoff + m * 2048 + k * 1024); } while (0)
#define PG8_LDB(dst, b, h) do { _Pragma("unroll") for (int n = 0; n < 2; ++n) _Pragma("unroll") for (int k = 0; k < 2; ++k) dst[n][k] = *(const PG8_LAS bf16x8*)(lds + PG8_SB(b, h) + boff + n * 2048 + k * 1024); } while (0)
#define PG8_MMA(ai, bj, At, Bt) do { __builtin_amdgcn_s_setprio(1); _Pragma("unroll") for (int m = 0; m < 4; ++m) _Pragma("unroll") for (int n = 0; n < 2; ++n) _Pragma("unroll") for (int k = 0; k < 2; ++k) \
        acc[ai][bj][m][n] = __builtin_amdgcn_mfma_f32_16x16x32_bf16(Bt[n][k], At[m][k], acc[ai][bj][m][n], 0, 0, 0); __builtin_amdgcn_s_setprio(0); } while (0)
#define PG8_WAIT_V(n) asm volatile("s_waitcnt vmcnt(" #n ")" ::: "memory")
#define PG8_WAIT_L(n) asm volatile("s_waitcnt lgkmcnt(" #n ")" ::: "memory")
#define PG8_BAR __builtin_amdgcn_s_barrier()
#define PG8_SCHED __builtin_amdgcn_sched_barrier(0)
    Unit cur, nxt; int ui = 0;
    if (!S.next(0, cur)) return;
    f32x4 acc[2][2][4][2];
#pragma unroll
    for (int a = 0; a < 2; ++a)
#pragma unroll
        for (int b = 0; b < 2; ++b)
#pragma unroll
            for (int m = 0; m < 4; ++m)
#pragma unroll
                for (int n = 0; n < 2; ++n) acc[a][b][m][n] = (f32x4){0.f, 0.f, 0.f, 0.f};
    bf16x8 At[4][2], B0[2][2], B1[2][2];
    const char* cA = (const char*)g.A + (size_t)cur.pm * tstepA + (size_t)cur.pn * akb; const char* cB = (const char*)g.Bt + (size_t)cur.pn * tstepB;
    S.a_ready(cur);
    if constexpr (SP2) {
        PG8_STAGE(PG8_SB(0, 0), cB, voffB); PG8_STAGE(PG8_SB(0, 1), cB + hstepB, voffB); PG8_STAGE(PG8_SA(0, 0), cA, voffA); PG8_STAGE(PG8_SA(0, 1), cA + hstepA, voffA);
        if (wr == 1) PG8_BAR;
        PG8_WAIT_V(2); PG8_BAR;
        PG8_STAGE(PG8_SB(1, 0), cB + kstep, voffB); PG8_STAGE(PG8_SA(1, 0), cA + kstep, voffA); PG8_STAGE(PG8_SB(1, 1), cB + hstepB + kstep, voffB);
        PG8_WAIT_V(6); PG8_BAR;
    } else {
        PG8_STAGE(PG8_SB(0, 0), cB, voffB); PG8_STAGE(PG8_SA(0, 0), cA, voffA); PG8_STAGE(PG8_SB(0, 1), cB + hstepB, voffB); PG8_STAGE(PG8_SA(0, 1), cA + hstepA, voffA);
        if (wr == 1) PG8_BAR;
        PG8_WAIT_V(4); PG8_BAR;
        PG8_STAGE(PG8_SB(1, 0), cB + kstep, voffB); PG8_STAGE(PG8_SA(1, 0), cA + kstep, voffA); PG8_STAGE(PG8_SB(1, 1), cB + hstepB + kstep, voffB);
        PG8_WAIT_V(6); PG8_BAR;
    }
    for (;;) {
        const bool has_next = S.next(ui + 1, nxt);
        const char* nA = has_next ? (const char*)g.A + (size_t)nxt.pm * tstepA + (size_t)nxt.pn * akb : cA; const char* nB = has_next ? (const char*)g.Bt + (size_t)nxt.pn * tstepB : cB;
#pragma nounroll
        for (int t = 0; t < nt; t += 2) {
            const bool last = (t == nt - 2);
            const char* a1 = cA + (size_t)(t + 1) * kstep;
            const char* a2 = last ? nA : cA + (size_t)(t + 2) * kstep; const char* b2 = last ? nB : cB + (size_t)(t + 2) * kstep;
            const char* a3 = a2 + kstep; const char* b3 = b2 + kstep;
            if (last && has_next) S.a_ready(nxt);
            if constexpr (SP2) {
            PG8_LDB(B0, 0, 0); PG8_LDB(B1, 0, 1); PG8_SCHED; PG8_LDA(At, 0, 0); PG8_STAGE(PG8_SA(1, 1), a1 + hstepA, voffA);
            PG8_WAIT_V(8); PG8_WAIT_L(0); PG8_BAR; PG8_MMA(0, 0, At, B0); PG8_MMA(0, 1, At, B1); PG8_BAR; PG8_SCHED;
            PG8_LDA(At, 0, 1); PG8_STAGE(PG8_SB(0, 0), b2, voffB); PG8_STAGE(PG8_SB(0, 1), b2 + hstepB, voffB); PG8_STAGE(PG8_SA(0, 0), a2, voffA);
            PG8_WAIT_V(8); PG8_WAIT_L(0); PG8_BAR; PG8_MMA(1, 0, At, B0); PG8_MMA(1, 1, At, B1); PG8_BAR; PG8_SCHED;
            PG8_LDB(B0, 1, 0); PG8_LDB(B1, 1, 1); PG8_SCHED; PG8_LDA(At, 1, 0); PG8_STAGE(PG8_SA(0, 1), a2 + hstepA, voffA);
            PG8_WAIT_V(8); PG8_WAIT_L(0); PG8_BAR; PG8_MMA(0, 0, At, B0); PG8_MMA(0, 1, At, B1); PG8_BAR; PG8_SCHED;
            PG8_LDA(At, 1, 1); PG8_STAGE(PG8_SB(1, 0), b3, voffB); PG8_STAGE(PG8_SB(1, 1), b3 + hstepB, voffB); PG8_STAGE(PG8_SA(1, 0), a3, voffA);
            PG8_WAIT_V(8); PG8_WAIT_L(0); PG8_BAR; PG8_MMA(1, 0, At, B0); PG8_MMA(1, 1, At, B1); PG8_BAR; PG8_SCHED;
            } else {
            PG8_LDB(B0, 0, 0); PG8_SCHED; PG8_LDA(At, 0, 0); PG8_STAGE(PG8_SA(1, 1), a1 + hstepA, voffA);
            PG8_WAIT_L(8); PG8_BAR; PG8_WAIT_L(0); PG8_MMA(0, 0, At, B0); PG8_BAR; PG8_SCHED;
            PG8_LDB(B1, 0, 1); PG8_STAGE(PG8_SB(0, 0), b2, voffB);
            PG8_BAR; PG8_WAIT_L(0); PG8_MMA(0, 1, At, B1); PG8_BAR;
            PG8_LDA(At, 0, 1); PG8_STAGE(PG8_SA(0, 0), a2, voffA);
            PG8_BAR; PG8_WAIT_L(0); PG8_MMA(1, 0, At, B0); PG8_BAR; PG8_SCHED;
            PG8_STAGE(PG8_SB(0, 1), b2 + hstepB, voffB);
            PG8_WAIT_V(6); PG8_BAR; PG8_MMA(1, 1, At, B1); PG8_BAR;
            PG8_LDB(B0, 1, 0); PG8_SCHED; PG8_LDA(At, 1, 0); PG8_STAGE(PG8_SA(0, 1), a2 + hstepA, voffA);
            PG8_WAIT_L(8); PG8_BAR; PG8_WAIT_L(0); PG8_MMA(0, 0, At, B0); PG8_BAR; PG8_SCHED;
            PG8_LDB(B1, 1, 1); PG8_STAGE(PG8_SB(1, 0), b3, voffB);
            PG8_BAR; PG8_WAIT_L(0); PG8_MMA(0, 1, At, B1); PG8_BAR;
            PG8_LDA(At, 1, 1); PG8_STAGE(PG8_SA(1, 0), a3, voffA);
            PG8_BAR; PG8_WAIT_L(0); PG8_MMA(1, 0, At, B0); PG8_BAR; PG8_SCHED;
            PG8_STAGE(PG8_SB(1, 1), b3 + hstepB, voffB);
            PG8_WAIT_V(6); PG8_BAR; PG8_MMA(1, 1, At, B1); PG8_BAR;
            }
        }
        if constexpr (ALIGN_EPI) { if (wr == 0) PG8_BAR; }
        if constexpr (!Epi::AFTER_DRAIN) { E(acc, cur, wr, wc, fr, fq); S.done(cur); }
        if (!has_next) break;
#pragma unroll
        for (int a = 0; a < 2; ++a)
#pragma unroll
            for (int b = 0; b < 2; ++b)
#pragma unroll
                for (int m = 0; m < 4; ++m)
#pragma unroll
                    for (int n = 0; n < 2; ++n) acc[a][b][m][n] = (f32x4){0.f, 0.f, 0.f, 0.f};
        cur = nxt; cA = nA; cB = nB; ++ui;
        if constexpr (ALIGN_EPI) { if (wr == 1) PG8_BAR; }
    }
    PG8_WAIT_V(0);
    if constexpr (!ALIGN_EPI) { if (wr == 0) PG8_BAR; }
    PG8_BAR;
    if constexpr (Epi::AFTER_DRAIN) { E.fused(acc, cur, wr, wc, fr, fq, lds, wid, lane); S.done(cur); }
#undef PG8_SA
#undef PG8_SB
#undef PG8_STAGE
#undef PG8_LDA
#undef PG8_LDB
#undef PG8_MMA
#undef PG8_WAIT_V
#undef PG8_WAIT_L
#undef PG8_BAR
#undef PG8_SCHED
}
}

#define LAS __attribute__((address_space(3)))
typedef unsigned short bf16;
typedef unsigned v4u __attribute__((ext_vector_type(4)));
typedef unsigned v2u __attribute__((ext_vector_type(2)));
typedef float f32x4 __attribute__((ext_vector_type(4)));
constexpr int DM = 2048, NB = 2, SEQ = 8192, DEPTH = 4, T = NB * SEQ, INC = 10240, NWAVES = 8;
constexpr int C_Q = 0, C_F = 1024, C_VA = 2048, C_ZA = 3072, C_VB = 4096, C_ZB = 5120, C_GA = 6144, C_GB = 8192;
constexpr float EPS = 1e-6f;
constexpr int LDS_BYTES = 147456;
constexpr size_t MiB = 1u << 20;
constexpr size_t WS_WIN = 0;
constexpr size_t WS_WPA = WS_WIN + 160 * MiB;
constexpr size_t WS_WPB = WS_WPA + 16 * MiB;
constexpr size_t WS_WOUT = WS_WPB + 16 * MiB;
constexpr size_t WS_WPOOL = WS_WOUT + 32 * MiB;
constexpr size_t WS_MODP = WS_WPOOL + 2 * MiB;
constexpr size_t WS_MOD = WS_MODP + 3 * MiB;
constexpr size_t WS_LB = WS_MOD + 512 * 1024;
constexpr size_t WS_H = WS_MOD + 1 * MiB;
constexpr size_t WS_PROJ = WS_H + 64 * MiB;
constexpr size_t WS_LF = WS_PROJ + 320 * MiB;
constexpr size_t WS_POOLED = WS_LF + 64 * MiB;
constexpr size_t WS_Y = WS_POOLED + 32 * MiB;
constexpr size_t WS_T1 = WS_Y + 64 * MiB;
constexpr size_t WS_MERGED = WS_T1 + 128 * MiB;
constexpr size_t WS_OUT = WS_MERGED + 64 * MiB;
constexpr size_t WS_G = WS_OUT + 64 * MiB;
constexpr size_t WS_S = WS_G + 16 * MiB;
constexpr size_t WS_END = WS_S + 16 * MiB;

__device__ __forceinline__ float bf2f(unsigned b) { return __uint_as_float(b << 16); }
__device__ __forceinline__ unsigned pk2(float lo, float hi) { return pg8::cvt_pk_bf16(lo, hi); }
__device__ __forceinline__ float sigm(float x) { return __builtin_amdgcn_rcpf(1.0f + __expf(-x)); }
__device__ __forceinline__ float wave_sum(float v) {
#pragma unroll
    for (int o = 1; o < 64; o <<= 1) v += __shfl_xor(v, o);
    return v;
}
#define LDS_WAIT() asm volatile("s_waitcnt lgkmcnt(0)" ::: "memory")

typedef pg8::f32x4 af4;
struct EpiProj {
    static constexpr bool PERM = true, AFTER_DRAIN = false;
    bf16* P; float* LF; const float* lb;
    __device__ __forceinline__ void operator()(const af4 (&acc)[2][2][4][2], const pg8::Unit& u, int wr, int wc, int fr, int fq) const {
        const int row0 = u.pm * 256 + wr * 64 + fr, colb = u.pn * 256 + wc * 32 + 8 * fq;
        const int pn = u.pn;
        const int mode = (pn < 4) ? 1 : (pn < 8) ? 3 : (pn < 12) ? 0 : (pn < 16) ? 1 : (pn < 20) ? 0 : (pn < 24) ? 1 : 2;
        if (mode == 3) {
            float lbv[2][8];
#pragma unroll
            for (int bj = 0; bj < 2; ++bj) { const f32x4 a = *(const f32x4*)(lb + colb - C_F + bj * 128), b = *(const f32x4*)(lb + colb - C_F + bj * 128 + 4);
                lbv[bj][0] = a[0]; lbv[bj][1] = a[1]; lbv[bj][2] = a[2]; lbv[bj][3] = a[3]; lbv[bj][4] = b[0]; lbv[bj][5] = b[1]; lbv[bj][6] = b[2]; lbv[bj][7] = b[3]; }
#pragma unroll
            for (int ai = 0; ai < 2; ++ai)
#pragma unroll
                for (int m = 0; m < 4; ++m) { const size_t row = (size_t)(row0 + ai * 128 + m * 16);
#pragma unroll
                    for (int bj = 0; bj < 2; ++bj) { float kk[8], lf[8];
#pragma unroll
                        for (int j = 0; j < 8; ++j) { const float a = acc[ai][bj][m][j >> 2][j & 3], l = lbv[bj][j];
                            const float sg = __builtin_amdgcn_rcpf(1.0f + __expf(-a)), sn = __builtin_amdgcn_rcpf(1.0f + __expf(a));
                            const float f = l + (1.0f - l) * sg; lf[j] = __logf(fmaxf(f, 1e-30f)); kk[j] = (1.0f - l) * sn; }
                        v4u w; w.x = pk2(kk[0], kk[1]); w.y = pk2(kk[2], kk[3]); w.z = pk2(kk[4], kk[5]); w.w = pk2(kk[6], kk[7]);
                        *(v4u*)(P + row * INC + colb + bj * 128) = w;
                        float* lp = LF + row * 1024 + (colb - C_F) + bj * 128;
                        *(f32x4*)lp = (f32x4){lf[0], lf[1], lf[2], lf[3]}; *(f32x4*)(lp + 4) = (f32x4){lf[4], lf[5], lf[6], lf[7]}; } }
        } else {
#pragma unroll
            for (int ai = 0; ai < 2; ++ai)
#pragma unroll
                for (int m = 0; m < 4; ++m) { const size_t row = (size_t)(row0 + ai * 128 + m * 16);
#pragma unroll
                    for (int bj = 0; bj < 2; ++bj) { float o[8];
#pragma unroll
                        for (int j = 0; j < 8; ++j) { const float a = acc[ai][bj][m][j >> 2][j & 3];
                            o[j] = (mode == 0) ? a : (mode == 1) ? a * sigm(a) : sigm(a); }
                        v4u w; w.x = pk2(o[0], o[1]); w.y = pk2(o[2], o[3]); w.z = pk2(o[4], o[5]); w.w = pk2(o[6], o[7]);
                        *(v4u*)(P + row * INC + colb + bj * 128) = w; } }
        }
    }
};
template <int MODE> struct EpiGen {
    static constexpr bool PERM = true, AFTER_DRAIN = false;
    bf16* O; int ldo; float* F; int ldf; const bf16* X; int ldx; const float* vec;
    __device__ __forceinline__ void operator()(const af4 (&acc)[2][2][4][2], const pg8::Unit& u, int wr, int wc, int fr, int fq) const {
        const int row0 = u.pm * 256 + wr * 64 + fr, colb = u.pn * 256 + wc * 32 + 8 * fq;
#pragma unroll
        for (int ai = 0; ai < 2; ++ai)
#pragma unroll
            for (int m = 0; m < 4; ++m) { const size_t row = (size_t)(row0 + ai * 128 + m * 16);
#pragma unroll
                for (int bj = 0; bj < 2; ++bj) { const int col = colb + bj * 128; float o[8];
#pragma unroll
                    for (int j = 0; j < 8; ++j) o[j] = acc[ai][bj][m][j >> 2][j & 3];
                    if (MODE != 0) { const v4u xw = *(const v4u*)(X + row * ldx + col);
                        const float x0 = bf2f(xw.x & 0xffffu), x1 = bf2f(xw.x >> 16), x2 = bf2f(xw.y & 0xffffu), x3 = bf2f(xw.y >> 16), x4 = bf2f(xw.z & 0xffffu), x5 = bf2f(xw.z >> 16), x6 = bf2f(xw.w & 0xffffu), x7 = bf2f(xw.w >> 16);
                        o[0] *= x0; o[1] *= x1; o[2] *= x2; o[3] *= x3; o[4] *= x4; o[5] *= x5; o[6] *= x6; o[7] *= x7; }
                    if (MODE == 1) { const f32x4 a = *(const f32x4*)(vec + col), b = *(const f32x4*)(vec + col + 4);
                        o[0] *= a[0]; o[1] *= a[1]; o[2] *= a[2]; o[3] *= a[3]; o[4] *= b[0]; o[5] *= b[1]; o[6] *= b[2]; o[7] *= b[3]; }
                    if (MODE == 2) { float* fp = F + row * ldf + col; *(f32x4*)fp = (f32x4){o[0], o[1], o[2], o[3]}; *(f32x4*)(fp + 4) = (f32x4){o[4], o[5], o[6], o[7]}; }
                    else { if (MODE == 3) { const float* fp = F + row * ldf + col; const f32x4 a = *(const f32x4*)fp, b = *(const f32x4*)(fp + 4);
                            o[0] += a[0]; o[1] += a[1]; o[2] += a[2]; o[3] += a[3]; o[4] += b[0]; o[5] += b[1]; o[6] += b[2]; o[7] += b[3]; }
                        v4u w; w.x = pk2(o[0], o[1]); w.y = pk2(o[2], o[3]); w.z = pk2(o[4], o[5]); w.w = pk2(o[6], o[7]);
                        *(v4u*)(O + row * ldo + col) = w; } }
                if (MODE != 0) asm volatile("" ::: "memory"); }
    }
};

struct Params {
    const float *x, *c, *w_ada, *b_ada, *norm_pre, *norm_post, *w_in, *lower_bounds, *hgrn_norm, *pool_w, *pool_scale, *w_proj_a, *w_proj_b, *w_out;
    float* out; unsigned char* ws;
};

__device__ __forceinline__ void transpose_item(const float* W, int K, int N, bf16* WT, LAS float* scr, int item, int lane) {
    const int nblk = N / 32, kb = item / nblk, nb = item % nblk, k0 = 64 * kb, n0 = 32 * nb;
#pragma unroll 8
    for (int i = 0; i < 32; ++i) { const int kk = 2 * i + (lane >> 5); scr[kk * 33 + (lane & 31)] = W[(size_t)(k0 + kk) * N + n0 + (lane & 31)]; }
    LDS_WAIT(); asm volatile("" ::: "memory");
    const int c = lane & 7;
#pragma unroll
    for (int j = 0; j < 4; ++j) { const int n = (lane >> 3) + 8 * j; const LAS float* s = scr + (8 * c) * 33 + n;
        v4u o; o.x = pk2(s[0 * 33], s[1 * 33]); o.y = pk2(s[2 * 33], s[3 * 33]); o.z = pk2(s[4 * 33], s[5 * 33]); o.w = pk2(s[6 * 33], s[7 * 33]);
        *(v4u*)(WT + (size_t)(n0 + n) * K + k0 + 8 * c) = o; }
    LDS_WAIT(); asm volatile("" ::: "memory");
}

__device__ __forceinline__ void phase0(const Params& p, LAS unsigned char* lds, int tid, int wave, int lane, int G, int bidx) {
    LAS float* cact = (LAS float*)lds;
    LAS float* scr = (LAS float*)(lds + 16384 + wave * 8704);
    for (int i = tid; i < NB * DM; i += NWAVES * 64) { const float v = p.c[i]; cact[i] = v * sigm(v); }
    __syncthreads();
    const int gw = bidx * NWAVES + wave, NGW = G * NWAVES;
    float* modp = (float*)(p.ws + WS_MODP);
    for (int it = gw; it < DEPTH * 24 * 16; it += NGW) {
        const int ks = it & 15, cgp = (it >> 4) % 24, l = it / (16 * 24);
        const int col0 = cgp * 256 + lane * 4, k0 = ks * 128;
        const float* w = p.w_ada + ((size_t)l * DM + k0) * 6144 + col0;
        f32x4 a0 = {0.f, 0.f, 0.f, 0.f}, a1 = {0.f, 0.f, 0.f, 0.f};
#pragma unroll 8
        for (int k = 0; k < 128; ++k) { const f32x4 wv = *(const f32x4*)(w + (size_t)k * 6144); const float c0 = cact[k0 + k], c1 = cact[DM + k0 + k]; a0 += wv * c0; a1 += wv * c1; }
        *(f32x4*)(modp + ((size_t)(ks * DEPTH + l) * 2 + 0) * 6144 + col0) = a0;
        *(f32x4*)(modp + ((size_t)(ks * DEPTH + l) * 2 + 1) * 6144 + col0) = a1;
    }
    constexpr int I_IN = 32 * 320, I_PA = 16 * 64, I_OUT = 32 * 64, I_POOL = 4 * 32, I_L = I_IN + 2 * I_PA + I_OUT + I_POOL;
    bf16* WIN = (bf16*)(p.ws + WS_WIN); bf16* WPA = (bf16*)(p.ws + WS_WPA); bf16* WPB = (bf16*)(p.ws + WS_WPB); bf16* WOUT = (bf16*)(p.ws + WS_WOUT); bf16* WPOOL = (bf16*)(p.ws + WS_WPOOL);
    for (int it = gw; it < DEPTH * I_L; it += NGW) {
        const int l = it / I_L; int r = it % I_L;
        if (r < I_IN) { transpose_item(p.w_in + (size_t)l * DM * INC, DM, INC, WIN + (size_t)l * INC * DM, scr, r, lane); continue; } r -= I_IN;
        if (r < I_PA) { transpose_item(p.w_proj_a + (size_t)l * 1024 * DM, 1024, DM, WPA + (size_t)l * DM * 1024, scr, r, lane); continue; } r -= I_PA;
        if (r < I_PA) { transpose_item(p.w_proj_b + (size_t)l * 1024 * DM, 1024, DM, WPB + (size_t)l * DM * 1024, scr, r, lane); continue; } r -= I_PA;
        if (r < I_OUT) { transpose_item(p.w_out + (size_t)l * DM * DM, DM, DM, WOUT + (size_t)l * DM * DM, scr, r, lane); continue; } r -= I_OUT;
        { const int g = r / 32; transpose_item(p.pool_w + (size_t)(l * 4 + g) * 65536, 256, 256, WPOOL + (size_t)(l * 1024 + g * 256) * 256, scr, r % 32, lane); }
    }
    if (bidx == 0) {
        float* lbo = (float*)(p.ws + WS_LB);
        for (int i = tid; i < 1024; i += NWAVES * 64) {
            const float v0 = p.lower_bounds[i], v1 = p.lower_bounds[1024 + i], v2 = p.lower_bounds[2048 + i], v3 = p.lower_bounds[3072 + i];
            const float mx = fmaxf(fmaxf(v0, v1), fmaxf(v2, v3));
            const float e0 = expf(v0 - mx), e1 = expf(v1 - mx), e2 = expf(v2 - mx), e3 = expf(v3 - mx), inv = 1.0f / (e0 + e1 + e2 + e3);
            lbo[i] = 0.f; lbo[1024 + i] = e1 * inv; lbo[2048 + i] = (e1 + e2) * inv; lbo[3072 + i] = (e1 + e2 + e3) * inv;
        }
    }
}
__device__ __forceinline__ void phase_mod(const Params& p, int tid, int G, int bidx) {
    const float* modp = (const float*)(p.ws + WS_MODP); float* mod = (float*)(p.ws + WS_MOD);
    for (int i = bidx * (NWAVES * 64) + tid; i < DEPTH * 2 * 6144; i += G * NWAVES * 64) {
        const int l = i / (2 * 6144), cidx = i % 6144;
        float s = p.b_ada[l * 6144 + cidx];
#pragma unroll
        for (int ks = 0; ks < 16; ++ks) s += modp[(size_t)ks * (DEPTH * 2 * 6144) + i];
        mod[i] = s;
    }
}
__device__ __forceinline__ void row_pass(const Params& p, int l, int wave, int lane, int G, int bidx) {
    const float* mod = (const float*)(p.ws + WS_MOD); const bf16* OUT = (const bf16*)(p.ws + WS_OUT); bf16* H = (bf16*)(p.ws + WS_H);
    const int gw = bidx * NWAVES + wave, NGW = G * NWAVES;
    for (int r = gw; r < T; r += NGW) {
        const int b = r >> 13;
        const float* xp = ((l <= 1) ? p.x : p.out) + (size_t)r * DM;
        f32x4 x[8];
#pragma unroll
        for (int j = 0; j < 8; ++j) x[j] = *(const f32x4*)(xp + j * 256 + lane * 4);
        if (l >= 1) {
            f32x4 o[8]; float ss = 0.f;
#pragma unroll
            for (int j = 0; j < 8; ++j) { const v2u w = *(const v2u*)(OUT + (size_t)r * DM + j * 256 + lane * 4);
                o[j] = (f32x4){bf2f(w.x & 0xffffu), bf2f(w.x >> 16), bf2f(w.y & 0xffffu), bf2f(w.y >> 16)};
                ss += (o[j][0] * o[j][0] + o[j][1] * o[j][1]) + (o[j][2] * o[j][2] + o[j][3] * o[j][3]); }
            const float rinv = rsqrtf(wave_sum(ss) * (1.0f / DM) + EPS);
            const float* gate = mod + (size_t)((l - 1) * 2 + b) * 6144 + 4096; const float* np = p.norm_post + (l - 1) * DM;
#pragma unroll
            for (int j = 0; j < 8; ++j) { const f32x4 g = *(const f32x4*)(gate + j * 256 + lane * 4), n = *(const f32x4*)(np + j * 256 + lane * 4);
                x[j] = x[j] + g * ((o[j] * rinv) * n);
                *(f32x4*)(p.out + (size_t)r * DM + j * 256 + lane * 4) = x[j]; }
        }
        if (l < DEPTH) {
            float ss = 0.f;
#pragma unroll
            for (int j = 0; j < 8; ++j) ss += (x[j][0] * x[j][0] + x[j][1] * x[j][1]) + (x[j][2] * x[j][2] + x[j][3] * x[j][3]);
            const float rinv = rsqrtf(wave_sum(ss) * (1.0f / DM) + EPS);
            const float* sh = mod + (size_t)(l * 2 + b) * 6144; const float* sc = sh + 2048; const float* npre = p.norm_pre + l * DM;
#pragma unroll
            for (int j = 0; j < 8; ++j) { const f32x4 s1 = *(const f32x4*)(sc + j * 256 + lane * 4), s0 = *(const f32x4*)(sh + j * 256 + lane * 4), n = *(const f32x4*)(npre + j * 256 + lane * 4);
                const f32x4 h = ((x[j] * rinv) * n) * (1.0f + s1) + s0;
                v2u w; w.x = pk2(h[0], h[1]); w.y = pk2(h[2], h[3]);
                *(v2u*)(H + (size_t)r * DM + j * 256 + lane * 4) = w; }
        }
    }
}
__device__ __forceinline__ void pooled_pass(const Params& p, int wave, int lane, int G, int bidx) {
    const bf16* P = (const bf16*)(p.ws + WS_PROJ); bf16* PO = (bf16*)(p.ws + WS_POOLED);
    const int gw = bidx * NWAVES + wave, NGW = G * NWAVES;
    for (int r = gw; r < T; r += NGW) {
        const int t = r & (SEQ - 1);
#pragma unroll
        for (int hf = 0; hf < 2; ++hf) {
            const int c = hf * 512 + lane * 8, w = 2 << (c >> 8), n = (t + 1 < w) ? t + 1 : w;
            float s[8], v0[8];
#pragma unroll
            for (int j = 0; j < 8; ++j) s[j] = 0.f;
            for (int i = 0; i < n; ++i) { const v4u q = *(const v4u*)(P + (size_t)(r - i) * INC + C_VB + c);
                const float e[8] = {bf2f(q.x & 0xffffu), bf2f(q.x >> 16), bf2f(q.y & 0xffffu), bf2f(q.y >> 16), bf2f(q.z & 0xffffu), bf2f(q.z >> 16), bf2f(q.w & 0xffffu), bf2f(q.w >> 16)};
#pragma unroll
                for (int j = 0; j < 8; ++j) { s[j] += e[j]; if (i == 0) v0[j] = e[j]; } }
            const float inv = 1.0f / (float)n;
            v4u o; o.x = pk2(s[0] * inv - v0[0], s[1] * inv - v0[1]); o.y = pk2(s[2] * inv - v0[2], s[3] * inv - v0[3]); o.z = pk2(s[4] * inv - v0[4], s[5] * inv - v0[5]); o.w = pk2(s[6] * inv - v0[6], s[7] * inv - v0[7]);
            *(v4u*)(PO + (size_t)r * 1024 + c) = o;
        }
    }
}
__device__ __forceinline__ void hgrn_naive(const Params& p, int job, int lane) {
    const bf16* P = (const bf16*)(p.ws + WS_PROJ); const float* LF = (const float*)(p.ws + WS_LF); float* OR = (float*)(p.ws + WS_T1);
    const int b = job >> 4, h = (job >> 1) & 7, vh = job & 1;
    float S[128];
#pragma unroll
    for (int k = 0; k < 128; ++k) S[k] = 0.f;
    const size_t r0 = (size_t)b * SEQ;
    const bf16* pr = P + r0 * INC + h * 128; const float* lr = LF + r0 * 1024 + h * 128;
    float nv = bf2f(pr[C_VA + vh * 64 + lane]), nq0 = bf2f(pr[C_Q + lane]), nq1 = bf2f(pr[C_Q + 64 + lane]), nk0 = bf2f(pr[C_F + lane]), nk1 = bf2f(pr[C_F + 64 + lane]), nl0 = lr[lane], nl1 = lr[64 + lane];
    for (int t = 0; t < SEQ; ++t) {
        const float v = nv, q0 = nq0, q1 = nq1, k0 = nk0, k1 = nk1, f0 = __expf(nl0), f1 = __expf(nl1);
        if (t + 1 < SEQ) { const bf16* pn = pr + (size_t)(t + 1) * INC; const float* ln = lr + (size_t)(t + 1) * 1024;
            nv = bf2f(pn[C_VA + vh * 64 + lane]); nq0 = bf2f(pn[C_Q + lane]); nq1 = bf2f(pn[C_Q + 64 + lane]); nk0 = bf2f(pn[C_F + lane]); nk1 = bf2f(pn[C_F + 64 + lane]); nl0 = ln[lane]; nl1 = ln[64 + lane]; }
        float o = 0.f;
#pragma unroll
        for (int k = 0; k < 64; ++k) {
            const float fk = __int_as_float(__builtin_amdgcn_readlane(__float_as_int(f0), k)), kk = __int_as_float(__builtin_amdgcn_readlane(__float_as_int(k0), k)), qk = __int_as_float(__builtin_amdgcn_readlane(__float_as_int(q0), k));
            S[k] = fmaf(fk, S[k], kk * v); o = fmaf(S[k], qk, o); if ((k & 7) == 7) __builtin_amdgcn_sched_barrier(0); }
#pragma unroll
        for (int k = 0; k < 64; ++k) {
            const float fk = __int_as_float(__builtin_amdgcn_readlane(__float_as_int(f1), k)), kk = __int_as_float(__builtin_amdgcn_readlane(__float_as_int(k1), k)), qk = __int_as_float(__builtin_amdgcn_readlane(__float_as_int(q1), k));
            S[64 + k] = fmaf(fk, S[64 + k], kk * v); o = fmaf(S[64 + k], qk, o); if ((k & 7) == 7) __builtin_amdgcn_sched_barrier(0); }
        OR[(r0 + t) * 1024 + h * 128 + vh * 64 + lane] = o;
    }
}
__device__ __forceinline__ void ya_pass(const Params& p, int l, int wave, int lane, int G, int bidx) {
    const bf16* P = (const bf16*)(p.ws + WS_PROJ); const float* OR = (const float*)(p.ws + WS_T1); bf16* Y = (bf16*)(p.ws + WS_Y);
    const int gw = bidx * NWAVES + wave, NGW = G * NWAVES;
    for (int r = gw; r < T; r += NGW) {
#pragma unroll
        for (int h = 0; h < 8; ++h) { const int c = h * 128 + lane * 2;
            const float o0 = OR[(size_t)r * 1024 + c], o1 = OR[(size_t)r * 1024 + c + 1];
            const float rinv = rsqrtf(wave_sum(o0 * o0 + o1 * o1) * (1.0f / 128.0f) + EPS);
            const unsigned z = *(const unsigned*)(P + (size_t)r * INC + C_ZA + c);
            const float g0 = p.hgrn_norm[l * 1024 + c], g1 = p.hgrn_norm[l * 1024 + c + 1];
            *(unsigned*)(Y + (size_t)r * DM + c) = pk2((o0 * rinv) * g0 * bf2f(z & 0xffffu), (o1 * rinv) * g1 * bf2f(z >> 16)); }
    }
}

#ifndef PHMASK
#define PHMASK 0xff
#endif
#define PHON(n) (((PHMASK) >> (n)) & 1)
#ifndef HGRN_NAIVE
#define HGRN_NAIVE 1
#endif
constexpr int LDS_PARAM_OFF = 131072 + 1024;
__device__ __forceinline__ void load_params(Params& q, LAS unsigned char* lds) {
    volatile LAS unsigned long long* s = (volatile LAS unsigned long long*)(lds + LDS_PARAM_OFF);
    unsigned long long v[16];
#pragma unroll
    for (int i = 0; i < 16; ++i) { const unsigned long long w = s[i]; v[i] = ((unsigned long long)(unsigned)__builtin_amdgcn_readfirstlane((int)(unsigned)(w >> 32)) << 32) | (unsigned)__builtin_amdgcn_readfirstlane((int)(unsigned)w); }
    q.x = (const float*)v[0]; q.c = (const float*)v[1]; q.w_ada = (const float*)v[2]; q.b_ada = (const float*)v[3]; q.norm_pre = (const float*)v[4]; q.norm_post = (const float*)v[5];
    q.w_in = (const float*)v[6]; q.lower_bounds = (const float*)v[7]; q.hgrn_norm = (const float*)v[8]; q.pool_w = (const float*)v[9]; q.pool_scale = (const float*)v[10];
    q.w_proj_a = (const float*)v[11]; q.w_proj_b = (const float*)v[12]; q.w_out = (const float*)v[13]; q.out = (float*)v[14]; q.ws = (unsigned char*)v[15];
}
#define LOADP(q) Params q; load_params(q, lds); unsigned char* ws = q.ws; (void)ws; int Gp = G, bx = (int)blockIdx.x, wv = wave, ln = lane, td = tid; asm volatile("" : "+s"(Gp), "+s"(bx), "+s"(wv), "+v"(ln), "+v"(td)); (void)Gp; (void)bx; (void)wv; (void)ln; (void)td
__global__ void __launch_bounds__(NWAVES * 64, 2) trunk_fwd(Params p) {
    extern __shared__ __attribute__((aligned(16))) unsigned char lds_raw[];
    cg::grid_group grid = cg::this_grid();
    LAS unsigned char* lds = (LAS unsigned char*)lds_raw;
    const int tid = threadIdx.x, lane = tid & 63, wave = __builtin_amdgcn_readfirstlane(tid >> 6), G = gridDim.x;
    if (tid == 0) { volatile LAS unsigned long long* s = (volatile LAS unsigned long long*)(lds + LDS_PARAM_OFF);
        s[0] = (unsigned long long)p.x; s[1] = (unsigned long long)p.c; s[2] = (unsigned long long)p.w_ada; s[3] = (unsigned long long)p.b_ada; s[4] = (unsigned long long)p.norm_pre; s[5] = (unsigned long long)p.norm_post;
        s[6] = (unsigned long long)p.w_in; s[7] = (unsigned long long)p.lower_bounds; s[8] = (unsigned long long)p.hgrn_norm; s[9] = (unsigned long long)p.pool_w; s[10] = (unsigned long long)p.pool_scale;
        s[11] = (unsigned long long)p.w_proj_a; s[12] = (unsigned long long)p.w_proj_b; s[13] = (unsigned long long)p.w_out; s[14] = (unsigned long long)p.out; s[15] = (unsigned long long)p.ws; }
    __syncthreads();

    { LOADP(q); phase0(q, lds, td, wv, ln, Gp, bx); }
    grid.sync();
    { LOADP(q); phase_mod(q, td, Gp, bx); }
    grid.sync();
    for (int l = 0; l < DEPTH; ++l) {
        { LOADP(q); row_pass(q, l, wv, ln, Gp, bx); }
        grid.sync();
        if (PHON(0)) {
            LOADP(q);
            pg8::Gemm g{(const bf16*)(ws + WS_H), (const bf16*)(ws + WS_WIN) + (size_t)l * INC * DM, T, INC, DM, DM, DM, 0}; pg8::StaticOrder S; S.init(T, INC, Gp, bx);
            EpiProj E{(bf16*)(ws + WS_PROJ), (float*)(ws + WS_LF), (const float*)(ws + WS_LB) + l * 1024};
            pg8::gemm_phase<EpiProj, pg8::StaticOrder, true, true>(lds, g, S, E);
        }
        grid.sync();
#if HGRN_NAIVE
        { LOADP(q);
          if (bx < 32) { if (wv == 0) hgrn_naive(q, bx, ln); }
          else pooled_pass(q, wv, ln, Gp - 32, bx - 32); }
        grid.sync();
        { LOADP(q); ya_pass(q, l, wv, ln, Gp, bx); }
#endif
        if (PHON(1)) {
            LOADP(q);
            pg8::Gemm g{(const bf16*)(ws + WS_POOLED), (const bf16*)(ws + WS_WPOOL) + (size_t)l * 1024 * 256, T, 1024, 256, 1024, 256, 256}; pg8::StaticOrder S; S.init(T, 1024, Gp, bx);
            EpiGen<1> E{(bf16*)(ws + WS_Y) + 1024, DM, nullptr, 0, (const bf16*)(ws + WS_PROJ) + C_ZB, INC, q.pool_scale + l * 1024};
            pg8::gemm_phase<EpiGen<1>, pg8::StaticOrder, true, true>(lds, g, S, E);
        }
        grid.sync();
        if (PHON(2)) {
            LOADP(q);
            pg8::Gemm g{(const bf16*)(ws + WS_Y), (const bf16*)(ws + WS_WPA) + (size_t)l * DM * 1024, T, DM, 1024, DM, 1024, 0}; pg8::StaticOrder S; S.init(T, DM, Gp, bx);
            EpiGen<2> E{nullptr, 0, (float*)(ws + WS_T1), DM, (const bf16*)(ws + WS_PROJ) + C_GA, INC, nullptr};
            pg8::gemm_phase<EpiGen<2>, pg8::StaticOrder, true, true>(lds, g, S, E);
        }
        if (PHON(3)) {
            LOADP(q);
            pg8::Gemm g{(const bf16*)(ws + WS_Y) + 1024, (const bf16*)(ws + WS_WPB) + (size_t)l * DM * 1024, T, DM, 1024, DM, 1024, 0}; pg8::StaticOrder S; S.init(T, DM, Gp, bx);
            EpiGen<3> E{(bf16*)(ws + WS_MERGED), DM, (float*)(ws + WS_T1), DM, (const bf16*)(ws + WS_PROJ) + C_GB, INC, nullptr};
            pg8::gemm_phase<EpiGen<3>, pg8::StaticOrder, true, true>(lds, g, S, E);
        }
        grid.sync();
        if (PHON(4)) {
            LOADP(q);
            pg8::Gemm g{(const bf16*)(ws + WS_MERGED), (const bf16*)(ws + WS_WOUT) + (size_t)l * DM * DM, T, DM, DM, DM, DM, 0}; pg8::StaticOrder S; S.init(T, DM, Gp, bx);
            EpiGen<0> E{(bf16*)(ws + WS_OUT), DM, nullptr, 0, nullptr, 0, nullptr};
            pg8::gemm_phase<EpiGen<0>, pg8::StaticOrder, true, true>(lds, g, S, E);
        }
        grid.sync();
    }
    { LOADP(q); row_pass(q, DEPTH, wv, ln, Gp, bx); }
}

extern "C" void kernel_launch(void* const* d_in, const int* in_sizes, int n_in, void* d_out, int out_size, void* d_ws, size_t ws_size, hipStream_t stream) {
    static int grid_blocks = 0;
    if (!grid_blocks) {
        if (n_in != 14 || out_size != T * DM || ws_size < WS_END) { fprintf(stderr, "kernel_launch: unexpected shapes (n_in %d out %d ws %zu, need %zu)\n", n_in, out_size, ws_size, (size_t)WS_END); grid_blocks = -1; return; }
        int dev = 0, cus = 0, per_cu = 0;
        hipGetDevice(&dev);
        hipDeviceGetAttribute(&cus, hipDeviceAttributeMultiprocessorCount, dev);
        if (hipFuncSetAttribute((const void*)trunk_fwd, hipFuncAttributeMaxDynamicSharedMemorySize, LDS_BYTES) != hipSuccess) fprintf(stderr, "kernel_launch: hipFuncSetAttribute failed\n");
        hipOccupancyMaxActiveBlocksPerMultiprocessor(&per_cu, trunk_fwd, NWAVES * 64, LDS_BYTES);
        if (per_cu < 1) per_cu = 1;
        grid_blocks = cus * 1;
        fprintf(stderr, "kernel_launch: cus %d per_cu %d grid %d\n", cus, per_cu, grid_blocks);
    }
    if (grid_blocks <= 0) return;
    Params p{};
    p.x = (const float*)d_in[0]; p.c = (const float*)d_in[1]; p.w_ada = (const float*)d_in[2]; p.b_ada = (const float*)d_in[3]; p.norm_pre = (const float*)d_in[4]; p.norm_post = (const float*)d_in[5];
    p.w_in = (const float*)d_in[6]; p.lower_bounds = (const float*)d_in[7]; p.hgrn_norm = (const float*)d_in[8]; p.pool_w = (const float*)d_in[9]; p.pool_scale = (const float*)d_in[10];
    p.w_proj_a = (const float*)d_in[11]; p.w_proj_b = (const float*)d_in[12]; p.w_out = (const float*)d_in[13];
    p.out = (float*)d_out; p.ws = (unsigned char*)d_ws;
    void* args[] = {&p};
    hipError_t e = hipLaunchCooperativeKernel((const void*)trunk_fwd, dim3(grid_blocks), dim3(NWAVES * 64), args, LDS_BYTES, stream);
    if (e != hipSuccess) fprintf(stderr, "kernel_launch: cooperative launch failed: %s (grid %d)\n", hipGetErrorString(e), grid_blocks);
}
```

```cpp
#include <hip/hip_runtime.h>
#include <hip/hip_cooperative_groups.h>
#include <cstdio>
#include <cstdint>
namespace cg = cooperative_groups;
namespace pg8 {
#define PG8_LAS __attribute__((address_space(3)))
typedef unsigned short bf16_t;
typedef short bf16x8 __attribute__((ext_vector_type(8)));
typedef float f32x4 __attribute__((ext_vector_type(4)));
typedef unsigned u32x4 __attribute__((ext_vector_type(4)));
constexpr int BM = 256, BK = 64, HALF = 128, HTB = HALF * BK * 2  , STAGE_BYTES = 8 * HTB, NXCD = 8, WGM = 8;

__host__ __device__ __forceinline__ int lds_byte(int r, int c) { const int st = (r >> 4) * 2 + (c >> 5), rr = r & 15, cc = c & 31, ob = rr * 64 + cc * 2; return st * 1024 + (ob ^ (((ob >> 9) & 1) << 5)); }
__host__ __device__ __forceinline__ void stage_rc(int b, int& R, int& C) { const int st = b / 1024, sb = b % 1024, swz = sb ^ (((sb >> 9) & 1) << 5); R = (st >> 1) * 16 + swz / 64; C = (st & 1) * 32 + (swz % 64) / 2; }
__host__ __device__ __forceinline__ int perm32(int rho) { const int n = rho >> 4, i = rho & 15; return 8 * (i >> 2) + 4 * n + (i & 3); }

struct Unit { int pm, pn; };
struct Gemm { const bf16_t* A; const bf16_t* Bt; int M, N, K, lda, ldb, akoff; };

struct StaticOrder {
    int nM, nN, nwg, G, c;
    __host__ __device__ void init(int M, int N, int G_, int c_) { nM = M / BM; nN = N / BM; nwg = nM * nN; G = G_; c = c_; }
    __host__ __device__ bool next(int i, Unit& u) const {
        const long L = (long)i * G + c; if (L >= nwg) return false;
        int wgid = (int)L; { const int q = nwg / NXCD, r = nwg % NXCD, xcd = wgid % NXCD, off = wgid / NXCD; wgid = (xcd < r ? xcd * (q + 1) : r * (q + 1) + (xcd - r) * q) + off; }
        const int nig = WGM * nN, gid = wgid / nig, fm = gid * WGM, gsz = (nM - fm) < WGM ? (nM - fm) : WGM;
        u.pm = fm + ((wgid % nig) % gsz); u.pn = (wgid % nig) / gsz; return true;
    }
    __device__ __forceinline__ void a_ready(const Unit&) const {}
    __device__ __forceinline__ void done(const Unit&) const {}
};
__device__ __forceinline__ unsigned cvt_pk_bf16(float lo, float hi) { unsigned r; asm volatile("v_cvt_pk_bf16_f32 %0, %1, %2" : "=v"(r) : "v"(lo), "v"(hi)); return r; }
template <class Epi, class Sched, bool ALIGN_EPI = false, bool SP2 = false>
__device__ __forceinline__ void gemm_phase(PG8_LAS unsigned char* lds, const Gemm g, const Sched& S, const Epi& E) {
    int tid_ = threadIdx.x; asm volatile("" : "+v"(tid_));
    const int tid = tid_, wid = __builtin_amdgcn_readfirstlane(tid >> 6), lane = tid & 63, wr = wid >> 2, wc = wid & 3, fr = lane & 15, fq = lane >> 4;
    const int K = g.K, nt = K / BK;
    unsigned voffA[2], voffB[2];
#pragma unroll
    for (int i = 0; i < 2; ++i) { int R, C; stage_rc(tid * 16 + i * 8192, R, C); const int Rb = Epi::PERM ? ((R & ~31) + perm32(R & 31)) : R;
        voffA[i] = (unsigned)(R * g.lda + C) * 2u; voffB[i] = (unsigned)(Rb * g.ldb + C) * 2u; }
    const size_t kstep = (size_t)(BK * 2);
    const size_t hstepA = (size_t)HALF * g.lda * 2, hstepB = (size_t)HALF * g.ldb * 2;
    const size_t tstepA = 2 * hstepA, tstepB = 2 * hstepB, akb = (size_t)g.akoff * 2;
    const unsigned ldsw = (unsigned)wid * 1024u;
    const int aoff = lds_byte(wr * 64 + fr, fq * 8), boff = lds_byte(wc * 32 + fr, fq * 8);
#define PG8_SA(b, h) (((b) * 2 + (h)) * HTB)
#define PG8_SB(b, h) ((4 + (b) * 2 + (h)) * HTB)
#define PG8_STAGE(bufoff, gbase, voff) do { _Pragma("unroll") for (int _i = 0; _i < 2; ++_i) \
        __builtin_amdgcn_global_load_lds((const unsigned*)((const char*)(gbase) + (voff)[_i]), (PG8_LAS unsigned*)(lds + (bufoff) + ldsw + _i * 8192), 16, 0, 0); } while (0)
#define PG8_LDA(dst, b, h) do { _Pragma("unroll") for (int m = 0; m < 4; ++m) _Pragma("unroll") for (int k = 0; k < 2; ++k) dst[m][k] = *(const PG8_LAS bf16x8*)(lds + PG8_SA(b, h) + aoff + m * 2048 + k * 1024); } while (0)
#define PG8_LDB(dst, b, h) do { _Pragma("unroll") for (int n = 0; n < 2; ++n) _Pragma("unroll") for (int k = 0; k < 2; ++k) dst[n][k] = *(const PG8_LAS bf16x8*)(lds + PG8_SB(b, h) + boff + n * 2048 + k * 1024); } while (0)
#define PG8_MMA(ai, bj, At, Bt) do { __builtin_amdgcn_s_setprio(1); _Pragma("unroll") for (int m = 0; m < 4; ++m) _Pragma("unroll") for (int n = 0; n < 2; ++n) _Pragma("unroll") for (int k = 0; k < 2; ++k) \
        acc[ai][bj][m][n] = __builtin_amdgcn_mfma_f32_16x16x32_bf16(Bt[n][k], At[m][k], acc[ai][bj][m][n], 0, 0, 0); __builtin_amdgcn_s_setprio(0); } while (0)
#define PG8_WAIT_V(n) asm volatile("s_waitcnt vmcnt(" #n ")" ::: "memory")
#define PG8_WAIT_L(n) asm volatile("s_waitcnt lgkmcnt(" #n ")" ::: "memory")
#define PG8_BAR __builtin_amdgcn_s_barrier()
#define PG8_SCHED __builtin_amdgcn_sched_barrier(0)
    Unit cur, nxt; int ui = 0;
    if (!S.next(0, cur)) return;
    f32x4 acc[2][2][4][2];
#pragma unroll
    for (int a = 0; a < 2; ++a)
#pragma unroll
        for (int b = 0; b < 2; ++b)
#pragma unroll
            for (int m = 0; m < 4; ++m)
#pragma unroll
                for (int n = 0; n < 2; ++n) acc[a][b][m][n] = (f32x4){0.f, 0.f, 0.f, 0.f};
    bf16x8 At[4][2], B0[2][2], B1[2][2];
    const char* cA = (const char*)g.A + (size_t)cur.pm * tstepA + (size_t)cur.pn * akb; const char* cB = (const char*)g.Bt + (size_t)cur.pn * tstepB;
    S.a_ready(cur);
    if constexpr (SP2) {
        PG8_STAGE(PG8_SB(0, 0), cB, voffB); PG8_STAGE(PG8_SB(0, 1), cB + hstepB, voffB); PG8_STAGE(PG8_SA(0, 0), cA, voffA); PG8_STAGE(PG8_SA(0, 1), cA + hstepA, voffA);
        if (wr == 1) PG8_BAR;
        PG8_WAIT_V(2); PG8_BAR;
        PG8_STAGE(PG8_SB(1, 0), cB + kstep, voffB); PG8_STAGE(PG8_SA(1, 0), cA + kstep, voffA); PG8_STAGE(PG8_SB(1, 1), cB + hstepB + kstep, voffB);
        PG8_WAIT_V(6); PG8_BAR;
    } else {
        PG8_STAGE(PG8_SB(0, 0), cB, voffB); PG8_STAGE(PG8_SA(0, 0), cA, voffA); PG8_STAGE(PG8_SB(0, 1), cB + hstepB, voffB); PG8_STAGE(PG8_SA(0, 1), cA + hstepA, voffA);
        if (wr == 1) PG8_BAR;
        PG8_WAIT_V(4); PG8_BAR;
        PG8_STAGE(PG8_SB(1, 0), cB + kstep, voffB); PG8_STAGE(PG8_SA(1, 0), cA + kstep, voffA); PG8_STAGE(PG8_SB(1, 1), cB + hstepB + kstep, voffB);
        PG8_WAIT_V(6); PG8_BAR;
    }
    for (;;) {
        const bool has_next = S.next(ui + 1, nxt);
        const char* nA = has_next ? (const char*)g.A + (size_t)nxt.pm * tstepA + (size_t)nxt.pn * akb : cA; const char* nB = has_next ? (const char*)g.Bt + (size_t)nxt.pn * tstepB : cB;
#pragma nounroll
        for (int t = 0; t < nt; t += 2) {
            const bool last = (t == nt - 2);
            const char* a1 = cA + (size_t)(t + 1) * kstep;
            const char* a2 = last ? nA : cA + (size_t)(t + 2) * kstep; const char* b2 = last ? nB : cB + (size_t)(t + 2) * kstep;
            const char* a3 = a2 + kstep; const char* b3 = b2 + kstep;
            if (last && has_next) S.a_ready(nxt);
            if constexpr (SP2) {
            PG8_LDB(B0, 0, 0); PG8_LDB(B1, 0, 1); PG8_SCHED; PG8_LDA(At, 0, 0); PG8_STAGE(PG8_SA(1, 1), a1 + hstepA, voffA);
            PG8_WAIT_V(8); PG8_WAIT_L(0); PG8_BAR; PG8_MMA(0, 0, At, B0); PG8_MMA(0, 1, At, B1); PG8_BAR; PG8_SCHED;
            PG8_LDA(At, 0, 1); PG8_STAGE(PG8_SB(0, 0), b2, voffB); PG8_STAGE(PG8_SB(0, 1), b2 + hstepB, voffB); PG8_STAGE(PG8_SA(0, 0), a2, voffA);
            PG8_WAIT_V(8); PG8_WAIT_L(0); PG8_BAR; PG8_MMA(1, 0, At, B0); PG8_MMA(1, 1, At, B1); PG8_BAR; PG8_SCHED;
            PG8_LDB(B0, 1, 0); PG8_LDB(B1, 1, 1); PG8_SCHED; PG8_LDA(At, 1, 0); PG8_STAGE(PG8_SA(0, 1), a2 + hstepA, voffA);
            PG8_WAIT_V(8); PG8_WAIT_L(0); PG8_BAR; PG8_MMA(0, 0, At, B0); PG8_MMA(0, 1, At, B1); PG8_BAR; PG8_SCHED;
            PG8_LDA(At, 1, 1); PG8_STAGE(PG8_SB(1, 0), b3, voffB); PG8_STAGE(PG8_SB(1, 1), b3 + hstepB, voffB); PG8_STAGE(PG8_SA(1, 0), a3, voffA);
            PG8_WAIT_V(8); PG8_WAIT_L(0); PG8_BAR; PG8_MMA(1, 0, At, B0); PG8_MMA(1, 1, At, B1); PG8_BAR; PG8_SCHED;
            } else {
            PG8_LDB(B0, 0, 0); PG8_SCHED; PG8_LDA(At, 0, 0); PG8_STAGE(PG8_SA(1, 1), a1 + hstepA, voffA);
            PG8_WAIT_L(8); PG8_BAR; PG8_WAIT_L(0); PG8_MMA(0, 0, At, B0); PG8_BAR; PG8_SCHED;
            PG8_LDB(B1, 0, 1); PG8_STAGE(PG8_SB(0, 0), b2, voffB);
            PG8_BAR; PG8_WAIT_L(0); PG8_MMA(0, 1, At, B1); PG8_BAR;
            PG8_LDA(At, 0, 1); PG8_STAGE(PG8_SA(0, 0), a2, voffA);
            PG8_BAR; PG8_WAIT_L(0); PG8_MMA(1, 0, At, B0); PG8_BAR; PG8_SCHED;
            PG8_STAGE(PG8_SB(0, 1), b2 + hstepB, voffB);
            PG8_WAIT_V(6); PG8_BAR; PG8_MMA(1, 1, At, B1); PG8_BAR;
            PG8_LDB(B0, 1, 0); PG8_SCHED; PG8_LDA(At, 1, 0); PG8_STAGE(PG8_SA(0, 1), a2 + hstepA, voffA);
            PG8_WAIT_L(8); PG8_BAR; PG8_WAIT_L(0); PG8_MMA(0, 0, At, B0); PG8_BAR; PG8_SCHED;
            PG8_LDB(B1, 1, 1); PG8_STAGE(PG8_SB(1, 0), b3, voffB);
            PG8_BAR; PG8_WAIT_L(0); PG8_MMA(0, 1, At, B1); PG8_BAR;
            PG8_LDA(At, 1, 1); PG8_STAGE(PG8_SA(1, 0), a3, voffA);
            PG8_BAR; PG8_WAIT_L(0); PG8_MMA(1, 0, At, B0); PG8_BAR; PG8_SCHED;
            PG8_STAGE(PG8_SB(1, 1), b3 + hstepB, voffB);
            PG8_WAIT_V(6); PG8_BAR; PG8_MMA(1, 1, At, B1); PG8_BAR;
            }
        }
        if constexpr (ALIGN_EPI) { if (wr == 0) PG8_BAR; }
        if constexpr (!Epi::AFTER_DRAIN) { E(acc, cur, wr, wc, fr, fq); S.done(cur); }
        if (!has_next) break;
#pragma unroll
        for (int a = 0; a < 2; ++a)
#pragma unroll
            for (int b = 0; b < 2; ++b)
#pragma unroll
                for (int m = 0; m < 4; ++m)
#pragma unroll
                    for (int n = 0; n < 2; ++n) acc[a][b][m][n] = (f32x4){0.f, 0.f, 0.f, 0.f};
        cur = nxt; cA = nA; cB = nB; ++ui;
        if constexpr (ALIGN_EPI) { if (wr == 1) PG8_BAR; }
    }
    PG8_WAIT_V(0);
    if constexpr (!ALIGN_EPI) { if (wr == 0) PG8_BAR; }
    PG8_BAR;
    if constexpr (Epi::AFTER_DRAIN) { E.fused(acc, cur, wr, wc, fr, fq, lds, wid, lane); S.done(cur); }
#undef PG8_SA
#undef PG8_SB
#undef PG8_STAGE
#undef PG8_LDA
#undef PG8_LDB
#undef PG8_MMA
#undef PG8_WAIT_V
#undef PG8_WAIT_L
#undef PG8_BAR
#undef PG8_SCHED
}
}

#define LAS __attribute__((address_space(3)))
typedef unsigned short bf16;
typedef unsigned v4u __attribute__((ext_vector_type(4)));
typedef unsigned v2u __attribute__((ext_vector_type(2)));
typedef float f32x4 __attribute__((ext_vector_type(4)));
typedef float f32x2 __attribute__((ext_vector_type(2)));
constexpr int DM = 2048, NB = 2, SEQ = 8192, DEPTH = 4, T = NB * SEQ, INC = 10240, NWAVES = 8;
constexpr int C_Q = 0, C_F = 1024, C_VA = 2048, C_ZA = 3072, C_VB = 4096, C_ZB = 5120, C_GA = 6144, C_GB = 8192;
constexpr float EPS = 1e-6f;
constexpr int LDS_BYTES = 147456;
constexpr size_t MiB = 1u << 20;
constexpr size_t WS_WIN = 0;
constexpr size_t WS_WPA = WS_WIN + 160 * MiB;
constexpr size_t WS_WPB = WS_WPA + 16 * MiB;
constexpr size_t WS_WOUT = WS_WPB + 16 * MiB;
constexpr size_t WS_WPOOL = WS_WOUT + 32 * MiB;
constexpr size_t WS_MODP = WS_WPOOL + 2 * MiB;
constexpr size_t WS_MOD = WS_MODP + 3 * MiB;
constexpr size_t WS_LB = WS_MOD + 512 * 1024;
constexpr size_t WS_H = WS_MOD + 1 * MiB;
constexpr size_t WS_PROJ = WS_H + 64 * MiB;
constexpr size_t WS_LF = WS_PROJ + 320 * MiB;
constexpr size_t WS_POOLED = WS_LF + 64 * MiB;
constexpr size_t WS_Y = WS_POOLED + 32 * MiB;
constexpr size_t WS_T1 = WS_Y + 64 * MiB;
constexpr size_t WS_MERGED = WS_T1 + 128 * MiB;
constexpr size_t WS_OUT = WS_MERGED + 64 * MiB;
constexpr size_t WS_G = WS_OUT + 64 * MiB;
constexpr size_t WS_S = WS_G + 16 * MiB;
constexpr size_t WS_END = WS_S + 16 * MiB;

__device__ __forceinline__ float bf2f(unsigned b) { return __uint_as_float(b << 16); }
__device__ __forceinline__ unsigned pk2(float lo, float hi) { return pg8::cvt_pk_bf16(lo, hi); }
__device__ __forceinline__ float sigm(float x) { return __builtin_amdgcn_rcpf(1.0f + __expf(-x)); }
__device__ __forceinline__ float wave_sum(float v) {
#pragma unroll
    for (int o = 1; o < 64; o <<= 1) v += __shfl_xor(v, o);
    return v;
}
#define LDS_WAIT() asm volatile("s_waitcnt lgkmcnt(0)" ::: "memory")

typedef pg8::f32x4 af4;
struct EpiProj {
    static constexpr bool PERM = true, AFTER_DRAIN = false;
    bf16* P; float* LF; const float* lb;
    __device__ __forceinline__ void operator()(const af4 (&acc)[2][2][4][2], const pg8::Unit& u, int wr, int wc, int fr, int fq) const {
        const int row0 = u.pm * 256 + wr * 64 + fr, colb = u.pn * 256 + wc * 32 + 8 * fq;
        const int pn = u.pn;
        const int mode = (pn < 4) ? 1 : (pn < 8) ? 3 : (pn < 12) ? 0 : (pn < 16) ? 1 : (pn < 20) ? 0 : (pn < 24) ? 1 : 2;
        if (mode == 3) {
            float lbv[2][8];
#pragma unroll
            for (int bj = 0; bj < 2; ++bj) { const f32x4 a = *(const f32x4*)(lb + colb - C_F + bj * 128), b = *(const f32x4*)(lb + colb - C_F + bj * 128 + 4);
                lbv[bj][0] = a[0]; lbv[bj][1] = a[1]; lbv[bj][2] = a[2]; lbv[bj][3] = a[3]; lbv[bj][4] = b[0]; lbv[bj][5] = b[1]; lbv[bj][6] = b[2]; lbv[bj][7] = b[3]; }
#pragma unroll
            for (int ai = 0; ai < 2; ++ai)
#pragma unroll
                for (int m = 0; m < 4; ++m) { const size_t row = (size_t)(row0 + ai * 128 + m * 16);
#pragma unroll
                    for (int bj = 0; bj < 2; ++bj) { float kk[8], lf[8];
#pragma unroll
                        for (int j = 0; j < 8; ++j) { const float a = acc[ai][bj][m][j >> 2][j & 3], l = lbv[bj][j];
                            const float sg = __builtin_amdgcn_rcpf(1.0f + __expf(-a)), sn = __builtin_amdgcn_rcpf(1.0f + __expf(a));
                            const float f = l + (1.0f - l) * sg; lf[j] = __logf(fmaxf(f, 1e-30f)); kk[j] = (1.0f - l) * sn; }
                        v4u w; w.x = pk2(kk[0], kk[1]); w.y = pk2(kk[2], kk[3]); w.z = pk2(kk[4], kk[5]); w.w = pk2(kk[6], kk[7]);
                        *(v4u*)(P + row * INC + colb + bj * 128) = w;
                        float* lp = LF + row * 1024 + (colb - C_F) + bj * 128;
                        *(f32x4*)lp = (f32x4){lf[0], lf[1], lf[2], lf[3]}; *(f32x4*)(lp + 4) = (f32x4){lf[4], lf[5], lf[6], lf[7]}; } }
        } else {
#pragma unroll
            for (int ai = 0; ai < 2; ++ai)
#pragma unroll
                for (int m = 0; m < 4; ++m) { const size_t row = (size_t)(row0 + ai * 128 + m * 16);
#pragma unroll
                    for (int bj = 0; bj < 2; ++bj) { float o[8];
#pragma unroll
                        for (int j = 0; j < 8; ++j) { const float a = acc[ai][bj][m][j >> 2][j & 3];
                            o[j] = (mode == 0) ? a : (mode == 1) ? a * sigm(a) : sigm(a); }
                        v4u w; w.x = pk2(o[0], o[1]); w.y = pk2(o[2], o[3]); w.z = pk2(o[4], o[5]); w.w = pk2(o[6], o[7]);
                        *(v4u*)(P + row * INC + colb + bj * 128) = w; } }
        }
    }
};
template <int MODE> struct EpiGen {
    static constexpr bool PERM = true, AFTER_DRAIN = false;
    bf16* O; int ldo; float* F; int ldf; const bf16* X; int ldx; const float* vec;
    __device__ __forceinline__ void operator()(const af4 (&acc)[2][2][4][2], const pg8::Unit& u, int wr, int wc, int fr, int fq) const {
        const int row0 = u.pm * 256 + wr * 64 + fr, colb = u.pn * 256 + wc * 32 + 8 * fq;
#pragma unroll
        for (int ai = 0; ai < 2; ++ai)
#pragma unroll
            for (int m = 0; m < 4; ++m) { const size_t row = (size_t)(row0 + ai * 128 + m * 16);
#pragma unroll
                for (int bj = 0; bj < 2; ++bj) { const int col = colb + bj * 128; float o[8];
#pragma unroll
                    for (int j = 0; j < 8; ++j) o[j] = acc[ai][bj][m][j >> 2][j & 3];
                    if (MODE != 0) { const v4u xw = *(const v4u*)(X + row * ldx + col);
                        const float x0 = bf2f(xw.x & 0xffffu), x1 = bf2f(xw.x >> 16), x2 = bf2f(xw.y & 0xffffu), x3 = bf2f(xw.y >> 16), x4 = bf2f(xw.z & 0xffffu), x5 = bf2f(xw.z >> 16), x6 = bf2f(xw.w & 0xffffu), x7 = bf2f(xw.w >> 16);
                        o[0] *= x0; o[1] *= x1; o[2] *= x2; o[3] *= x3; o[4] *= x4; o[5] *= x5; o[6] *= x6; o[7] *= x7; }
                    if (MODE == 1) { const f32x4 a = *(const f32x4*)(vec + col), b = *(const f32x4*)(vec + col + 4);
                        o[0] *= a[0]; o[1] *= a[1]; o[2] *= a[2]; o[3] *= a[3]; o[4] *= b[0]; o[5] *= b[1]; o[6] *= b[2]; o[7] *= b[3]; }
                    if (MODE == 2) { float* fp = F + row * ldf + col; *(f32x4*)fp = (f32x4){o[0], o[1], o[2], o[3]}; *(f32x4*)(fp + 4) = (f32x4){o[4], o[5], o[6], o[7]}; }
                    else { if (MODE == 3) { const float* fp = F + row * ldf + col; const f32x4 a = *(const f32x4*)fp, b = *(const f32x4*)(fp + 4);
                            o[0] += a[0]; o[1] += a[1]; o[2] += a[2]; o[3] += a[3]; o[4] += b[0]; o[5] += b[1]; o[6] += b[2]; o[7] += b[3]; }
                        v4u w; w.x = pk2(o[0], o[1]); w.y = pk2(o[2], o[3]); w.z = pk2(o[4], o[5]); w.w = pk2(o[6], o[7]);
                        *(v4u*)(O + row * ldo + col) = w; } }
                if (MODE != 0) asm volatile("" ::: "memory"); }
    }
};

struct Params {
    const float *x, *c, *w_ada, *b_ada, *norm_pre, *norm_post, *w_in, *lower_bounds, *hgrn_norm, *pool_w, *pool_scale, *w_proj_a, *w_proj_b, *w_out;
    float* out; unsigned char* ws;
};

__device__ __forceinline__ void transpose_item(const float* W, int K, int N, bf16* WT, LAS float* scr, int item, int lane) {
    const int nblk = N / 32, kb = item / nblk, nb = item % nblk, k0 = 64 * kb, n0 = 32 * nb;
#pragma unroll 8
    for (int i = 0; i < 32; ++i) { const int kk = 2 * i + (lane >> 5); scr[kk * 33 + (lane & 31)] = W[(size_t)(k0 + kk) * N + n0 + (lane & 31)]; }
    LDS_WAIT(); asm volatile("" ::: "memory");
    const int c = lane & 7;
#pragma unroll
    for (int j = 0; j < 4; ++j) { const int n = (lane >> 3) + 8 * j; const LAS float* s = scr + (8 * c) * 33 + n;
        v4u o; o.x = pk2(s[0 * 33], s[1 * 33]); o.y = pk2(s[2 * 33], s[3 * 33]); o.z = pk2(s[4 * 33], s[5 * 33]); o.w = pk2(s[6 * 33], s[7 * 33]);
        *(v4u*)(WT + (size_t)(n0 + n) * K + k0 + 8 * c) = o; }
    LDS_WAIT(); asm volatile("" ::: "memory");
}

__device__ __forceinline__ void phase0(const Params& p, LAS unsigned char* lds, int tid, int wave, int lane, int G, int bidx) {
    LAS float* cact = (LAS float*)lds;
    LAS float* scr = (LAS float*)(lds + 16384 + wave * 8704);
    for (int i = tid; i < NB * DM; i += NWAVES * 64) { const float v = p.c[i]; cact[i] = v * sigm(v); }
    __syncthreads();
    const int gw = bidx * NWAVES + wave, NGW = G * NWAVES;
    float* modp = (float*)(p.ws + WS_MODP);
    for (int it = gw; it < DEPTH * 24 * 16; it += NGW) {
        const int ks = it & 15, cgp = (it >> 4) % 24, l = it / (16 * 24);
        const int col0 = cgp * 256 + lane * 4, k0 = ks * 128;
        const float* w = p.w_ada + ((size_t)l * DM + k0) * 6144 + col0;
        f32x4 a0 = {0.f, 0.f, 0.f, 0.f}, a1 = {0.f, 0.f, 0.f, 0.f};
#pragma unroll 8
        for (int k = 0; k < 128; ++k) { const f32x4 wv = *(const f32x4*)(w + (size_t)k * 6144); const float c0 = cact[k0 + k], c1 = cact[DM + k0 + k]; a0 += wv * c0; a1 += wv * c1; }
        *(f32x4*)(modp + ((size_t)(ks * DEPTH + l) * 2 + 0) * 6144 + col0) = a0;
        *(f32x4*)(modp + ((size_t)(ks * DEPTH + l) * 2 + 1) * 6144 + col0) = a1;
    }
    constexpr int I_IN = 32 * 320, I_PA = 16 * 64, I_OUT = 32 * 64, I_POOL = 4 * 32, I_L = I_IN + 2 * I_PA + I_OUT + I_POOL;
    bf16* WIN = (bf16*)(p.ws + WS_WIN); bf16* WPA = (bf16*)(p.ws + WS_WPA); bf16* WPB = (bf16*)(p.ws + WS_WPB); bf16* WOUT = (bf16*)(p.ws + WS_WOUT); bf16* WPOOL = (bf16*)(p.ws + WS_WPOOL);
    for (int it = gw; it < DEPTH * I_L; it += NGW) {
        const int l = it / I_L; int r = it % I_L;
        if (r < I_IN) { transpose_item(p.w_in + (size_t)l * DM * INC, DM, INC, WIN + (size_t)l * INC * DM, scr, r, lane); continue; } r -= I_IN;
        if (r < I_PA) { transpose_item(p.w_proj_a + (size_t)l * 1024 * DM, 1024, DM, WPA + (size_t)l * DM * 1024, scr, r, lane); continue; } r -= I_PA;
        if (r < I_PA) { transpose_item(p.w_proj_b + (size_t)l * 1024 * DM, 1024, DM, WPB + (size_t)l * DM * 1024, scr, r, lane); continue; } r -= I_PA;
        if (r < I_OUT) { transpose_item(p.w_out + (size_t)l * DM * DM, DM, DM, WOUT + (size_t)l * DM * DM, scr, r, lane); continue; } r -= I_OUT;
        { const int g = r / 32; transpose_item(p.pool_w + (size_t)(l * 4 + g) * 65536, 256, 256, WPOOL + (size_t)(l * 1024 + g * 256) * 256, scr, r % 32, lane); }
    }
    if (bidx == 0) {
        float* lbo = (float*)(p.ws + WS_LB);
        for (int i = tid; i < 1024; i += NWAVES * 64) {
            const float v0 = p.lower_bounds[i], v1 = p.lower_bounds[1024 + i], v2 = p.lower_bounds[2048 + i], v3 = p.lower_bounds[3072 + i];
            const float mx = fmaxf(fmaxf(v0, v1), fmaxf(v2, v3));
            const float e0 = expf(v0 - mx), e1 = expf(v1 - mx), e2 = expf(v2 - mx), e3 = expf(v3 - mx), inv = 1.0f / (e0 + e1 + e2 + e3);
            lbo[i] = 0.f; lbo[1024 + i] = e1 * inv; lbo[2048 + i] = (e1 + e2) * inv; lbo[3072 + i] = (e1 + e2 + e3) * inv;
        }
    }
}
__device__ __forceinline__ void phase_mod(const Params& p, int tid, int G, int bidx) {
    const float* modp = (const float*)(p.ws + WS_MODP); float* mod = (float*)(p.ws + WS_MOD);
    for (int i = bidx * (NWAVES * 64) + tid; i < DEPTH * 2 * 6144; i += G * NWAVES * 64) {
        const int l = i / (2 * 6144), cidx = i % 6144;
        float s = p.b_ada[l * 6144 + cidx];
#pragma unroll
        for (int ks = 0; ks < 16; ++ks) s += modp[(size_t)ks * (DEPTH * 2 * 6144) + i];
        mod[i] = s;
    }
}
__device__ __forceinline__ void row_pass(const Params& p, int l, int wave, int lane, int G, int bidx) {
    const float* mod = (const float*)(p.ws + WS_MOD); const bf16* OUT = (const bf16*)(p.ws + WS_OUT); bf16* H = (bf16*)(p.ws + WS_H);
    const int gw = bidx * NWAVES + wave, NGW = G * NWAVES;
    for (int r = gw; r < T; r += NGW) {
        const int b = r >> 13;
        const float* xp = ((l <= 1) ? p.x : p.out) + (size_t)r * DM;
        f32x4 x[8];
#pragma unroll
        for (int j = 0; j < 8; ++j) x[j] = *(const f32x4*)(xp + j * 256 + lane * 4);
        if (l >= 1) {
            f32x4 o[8]; float ss = 0.f;
#pragma unroll
            for (int j = 0; j < 8; ++j) { const v2u w = *(const v2u*)(OUT + (size_t)r * DM + j * 256 + lane * 4);
                o[j] = (f32x4){bf2f(w.x & 0xffffu), bf2f(w.x >> 16), bf2f(w.y & 0xffffu), bf2f(w.y >> 16)};
                ss += (o[j][0] * o[j][0] + o[j][1] * o[j][1]) + (o[j][2] * o[j][2] + o[j][3] * o[j][3]); }
            const float rinv = rsqrtf(wave_sum(ss) * (1.0f / DM) + EPS);
            const float* gate = mod + (size_t)((l - 1) * 2 + b) * 6144 + 4096; const float* np = p.norm_post + (l - 1) * DM;
#pragma unroll
            for (int j = 0; j < 8; ++j) { const f32x4 g = *(const f32x4*)(gate + j * 256 + lane * 4), n = *(const f32x4*)(np + j * 256 + lane * 4);
                x[j] = x[j] + g * ((o[j] * rinv) * n);
                *(f32x4*)(p.out + (size_t)r * DM + j * 256 + lane * 4) = x[j]; }
        }
        if (l < DEPTH) {
            float ss = 0.f;
#pragma unroll
            for (int j = 0; j < 8; ++j) ss += (x[j][0] * x[j][0] + x[j][1] * x[j][1]) + (x[j][2] * x[j][2] + x[j][3] * x[j][3]);
            const float rinv = rsqrtf(wave_sum(ss) * (1.0f / DM) + EPS);
            const float* sh = mod + (size_t)(l * 2 + b) * 6144; const float* sc = sh + 2048; const float* npre = p.norm_pre + l * DM;
#pragma unroll
            for (int j = 0; j < 8; ++j) { const f32x4 s1 = *(const f32x4*)(sc + j * 256 + lane * 4), s0 = *(const f32x4*)(sh + j * 256 + lane * 4), n = *(const f32x4*)(npre + j * 256 + lane * 4);
                const f32x4 h = ((x[j] * rinv) * n) * (1.0f + s1) + s0;
                v2u w; w.x = pk2(h[0], h[1]); w.y = pk2(h[2], h[3]);
                *(v2u*)(H + (size_t)r * DM + j * 256 + lane * 4) = w; }
        }
    }
}
__device__ __forceinline__ void pooled_pass(const Params& p, int wave, int lane, int G, int bidx) {
    const bf16* P = (const bf16*)(p.ws + WS_PROJ); bf16* PO = (bf16*)(p.ws + WS_POOLED);
    const int gw = bidx * NWAVES + wave, NGW = G * NWAVES;
    for (int r = gw; r < T; r += NGW) {
        const int t = r & (SEQ - 1);
#pragma unroll
        for (int hf = 0; hf < 2; ++hf) {
            const int c = hf * 512 + lane * 8, w = 2 << (c >> 8), n = (t + 1 < w) ? t + 1 : w;
            float s[8], v0[8];
#pragma unroll
            for (int j = 0; j < 8; ++j) s[j] = 0.f;
            for (int i = 0; i < n; ++i) { const v4u q = *(const v4u*)(P + (size_t)(r - i) * INC + C_VB + c);
                const float e[8] = {bf2f(q.x & 0xffffu), bf2f(q.x >> 16), bf2f(q.y & 0xffffu), bf2f(q.y >> 16), bf2f(q.z & 0xffffu), bf2f(q.z >> 16), bf2f(q.w & 0xffffu), bf2f(q.w >> 16)};
#pragma unroll
                for (int j = 0; j < 8; ++j) { s[j] += e[j]; if (i == 0) v0[j] = e[j]; } }
            const float inv = 1.0f / (float)n;
            v4u o; o.x = pk2(s[0] * inv - v0[0], s[1] * inv - v0[1]); o.y = pk2(s[2] * inv - v0[2], s[3] * inv - v0[3]); o.z = pk2(s[4] * inv - v0[4], s[5] * inv - v0[5]); o.w = pk2(s[6] * inv - v0[6], s[7] * inv - v0[7]);
            *(v4u*)(PO + (size_t)r * 1024 + c) = o;
        }
    }
}
__device__ __forceinline__ void hgrn_naive(const Params& p, int job, int lane) {
    const bf16* P = (const bf16*)(p.ws + WS_PROJ); const float* LF = (const float*)(p.ws + WS_LF); float* OR = (float*)(p.ws + WS_T1);
    const int b = job >> 4, h = (job >> 1) & 7, vh = job & 1;
    float S[128];
#pragma unroll
    for (int k = 0; k < 128; ++k) S[k] = 0.f;
    const size_t r0 = (size_t)b * SEQ;
    const bf16* pr = P + r0 * INC + h * 128; const float* lr = LF + r0 * 1024 + h * 128;
    float nv = bf2f(pr[C_VA + vh * 64 + lane]), nq0 = bf2f(pr[C_Q + lane]), nq1 = bf2f(pr[C_Q + 64 + lane]), nk0 = bf2f(pr[C_F + lane]), nk1 = bf2f(pr[C_F + 64 + lane]), nl0 = lr[lane], nl1 = lr[64 + lane];
    for (int t = 0; t < SEQ; ++t) {
        const float v = nv, q0 = nq0, q1 = nq1, k0 = nk0, k1 = nk1, f0 = __expf(nl0), f1 = __expf(nl1);
        if (t + 1 < SEQ) { const bf16* pn = pr + (size_t)(t + 1) * INC; const float* ln = lr + (size_t)(t + 1) * 1024;
            nv = bf2f(pn[C_VA + vh * 64 + lane]); nq0 = bf2f(pn[C_Q + lane]); nq1 = bf2f(pn[C_Q + 64 + lane]); nk0 = bf2f(pn[C_F + lane]); nk1 = bf2f(pn[C_F + 64 + lane]); nl0 = ln[lane]; nl1 = ln[64 + lane]; }
        float o = 0.f;
#pragma unroll
        for (int k = 0; k < 64; ++k) {
            const float fk = __int_as_float(__builtin_amdgcn_readlane(__float_as_int(f0), k)), kk = __int_as_float(__builtin_amdgcn_readlane(__float_as_int(k0), k)), qk = __int_as_float(__builtin_amdgcn_readlane(__float_as_int(q0), k));
            S[k] = fmaf(fk, S[k], kk * v); o = fmaf(S[k], qk, o); if ((k & 7) == 7) __builtin_amdgcn_sched_barrier(0); }
#pragma unroll
        for (int k = 0; k < 64; ++k) {
            const float fk = __int_as_float(__builtin_amdgcn_readlane(__float_as_int(f1), k)), kk = __int_as_float(__builtin_amdgcn_readlane(__float_as_int(k1), k)), qk = __int_as_float(__builtin_amdgcn_readlane(__float_as_int(q1), k));
            S[64 + k] = fmaf(fk, S[64 + k], kk * v); o = fmaf(S[64 + k], qk, o); if ((k & 7) == 7) __builtin_amdgcn_sched_barrier(0); }
        OR[(r0 + t) * 1024 + h * 128 + vh * 64 + lane] = o;
    }
}
__device__ __forceinline__ void ya_pass(const Params& p, int l, int wave, int lane, int G, int bidx) {
    const bf16* P = (const bf16*)(p.ws + WS_PROJ); const float* OR = (const float*)(p.ws + WS_T1); bf16* Y = (bf16*)(p.ws + WS_Y);
    const int gw = bidx * NWAVES + wave, NGW = G * NWAVES;
    for (int r = gw; r < T; r += NGW) {
#pragma unroll
        for (int h = 0; h < 8; ++h) { const int c = h * 128 + lane * 2;
            const float o0 = OR[(size_t)r * 1024 + c], o1 = OR[(size_t)r * 1024 + c + 1];
            const float rinv = rsqrtf(wave_sum(o0 * o0 + o1 * o1) * (1.0f / 128.0f) + EPS);
            const unsigned z = *(const unsigned*)(P + (size_t)r * INC + C_ZA + c);
            const float g0 = p.hgrn_norm[l * 1024 + c], g1 = p.hgrn_norm[l * 1024 + c + 1];
            *(unsigned*)(Y + (size_t)r * DM + c) = pk2((o0 * rinv) * g0 * bf2f(z & 0xffffu), (o1 * rinv) * g1 * bf2f(z >> 16)); }
    }
}

#ifndef PHMASK
#define PHMASK 0xff
#endif
#define PHON(n) (((PHMASK) >> (n)) & 1)
#ifndef HGRN_NAIVE
#define HGRN_NAIVE 0
#endif
typedef short bf16x8 __attribute__((ext_vector_type(8)));
constexpr int L_QT = 0, L_KH = 17408, L_KT = 34816, L_VT = 53248, L_ST = 71680, L_P = 106496, L_SEG = 115712, L_D = 119808, L_SS = 120320;
template <bool FULL>
__device__ __forceinline__ void hgrn_chunks(const Params& p, LAS unsigned char* lds, int l, int item, int tid, int wave, int lane) {
    const bf16* P = (const bf16*)(p.ws + WS_PROJ); const float* LF = (const float*)(p.ws + WS_LF); float* Gbuf = (float*)(p.ws + WS_G); float* Dt = (float*)(p.ws + WS_S); bf16* Y = (bf16*)(p.ws + WS_Y);
    const int sc = item & 15, h = (item >> 4) & 7, b = item >> 7;
    const int cp = lane, seg = wave;
    const int fr = lane & 15, fq = lane >> 4;
    f32x4 S[8];
#pragma unroll
    for (int vt = 0; vt < 8; ++vt) S[vt] = (f32x4){0.f, 0.f, 0.f, 0.f};
    if (FULL) {
        for (int j = 0; j < sc; ++j) { const int ij = item - sc + j;
            const f32x4 dj = *(const f32x4*)(Dt + (size_t)ij * 128 + 16 * wave + fq * 4);
#pragma unroll
            for (int vt = 0; vt < 8; ++vt) { const f32x4 g = *(const f32x4*)(Gbuf + (size_t)ij * 16384 + (size_t)(vt * 512 + tid) * 4); S[vt] = dj * S[vt] + g; } }
    }
    f32x4 hn[4];
    if (FULL) {
#pragma unroll
        for (int j = 0; j < 4; ++j) hn[j] = *(const f32x4*)(p.hgrn_norm + l * 1024 + h * 128 + 16 * (4 * (wave & 1) + j) + fq * 4);
    }
    float tot0 = 0.f, tot1 = 0.f;
    const size_t rowsc = (size_t)b * SEQ + (size_t)sc * 512;
    for (int c = 0; c < 8; ++c) {
        const size_t row0 = rowsc + c * 64, rb = row0 + seg * 8;
        float b0[8], b1[8]; unsigned kw[8], vw[8], qw[8];
#pragma unroll
        for (int i = 0; i < 8; ++i) { const f32x2 f2 = *(const f32x2*)(LF + (rb + i) * 1024 + h * 128 + 2 * cp); b0[i] = f2.x; b1[i] = f2.y;
            const bf16* pr = P + (rb + i) * INC + h * 128 + 2 * cp;
            kw[i] = *(const unsigned*)(pr + C_F); vw[i] = *(const unsigned*)(pr + C_VA); if (FULL) qw[i] = *(const unsigned*)(pr + C_Q); }
#pragma unroll
        for (int i = 1; i < 8; ++i) { b0[i] += b0[i - 1]; b1[i] += b1[i - 1]; }
        *(LAS f32x2*)(lds + L_SEG + (seg * 128 + 2 * cp) * 4) = (f32x2){b0[7], b1[7]};
        __syncthreads();
        float off0 = 0.f, off1 = 0.f, mid0 = 0.f, mid1 = 0.f, t0 = 0.f, t1 = 0.f;
#pragma unroll
        for (int s = 0; s < 8; ++s) { const f32x2 st = *(const LAS f32x2*)(lds + L_SEG + (s * 128 + 2 * cp) * 4);
            if (s == seg) { off0 = t0; off1 = t1; } if (s == 4) { mid0 = t0; mid1 = t1; } t0 += st.x; t1 += st.y; }
        tot0 += t0; tot1 += t1;
        {
            unsigned kt0[4], kt1[4], vt0[4], vt1[4];
#pragma unroll
            for (int i = 0; i < 8; i += 2) {
                float k0[2], k1[2], v0[2], v1[2];
#pragma unroll
                for (int u = 0; u < 2; ++u) { const int ii = i + u; const float bt0 = off0 + b0[ii], bt1 = off1 + b1[ii];
                    const float kk0 = bf2f(kw[ii] & 0xffffu), kk1 = bf2f(kw[ii] >> 16);
                    k0[u] = kk0 * __expf(t0 - bt0); k1[u] = kk1 * __expf(t1 - bt1); v0[u] = bf2f(vw[ii] & 0xffffu); v1[u] = bf2f(vw[ii] >> 16);
                    if (FULL) { const float e0 = __expf(bt0 - mid0), e1 = __expf(bt1 - mid1), r0 = __expf(mid0 - bt0), r1 = __expf(mid1 - bt1);
                        *(LAS unsigned*)(lds + L_QT + (seg * 8 + ii) * 272 + cp * 4) = pk2(bf2f(qw[ii] & 0xffffu) * e0, bf2f(qw[ii] >> 16) * e1);
                        *(LAS unsigned*)(lds + L_KH + (seg * 8 + ii) * 272 + cp * 4) = pk2(kk0 * r0, kk1 * r1); } }
                kt0[i >> 1] = pk2(k0[0], k0[1]); kt1[i >> 1] = pk2(k1[0], k1[1]); vt0[i >> 1] = pk2(v0[0], v0[1]); vt1[i >> 1] = pk2(v1[0], v1[1]); }
            *(LAS v4u*)(lds + L_KT + (2 * cp) * 144 + seg * 16) = (v4u){kt0[0], kt0[1], kt0[2], kt0[3]};
            *(LAS v4u*)(lds + L_KT + (2 * cp + 1) * 144 + seg * 16) = (v4u){kt1[0], kt1[1], kt1[2], kt1[3]};
            *(LAS v4u*)(lds + L_VT + (2 * cp) * 144 + seg * 16) = (v4u){vt0[0], vt0[1], vt0[2], vt0[3]};
            *(LAS v4u*)(lds + L_VT + (2 * cp + 1) * 144 + seg * 16) = (v4u){vt1[0], vt1[1], vt1[2], vt1[3]};
            if (seg == 0) *(LAS f32x2*)(lds + L_D + 2 * cp * 4) = (f32x2){__expf(t0), __expf(t1)};
        }
        if (FULL) {
            f32x4 m4 = {0.f, 0.f, 0.f, 0.f};
#pragma unroll
            for (int s = 0; s < 4; ++s) m4 += *(const LAS f32x4*)(lds + L_SEG + (s * 128 + 16 * wave + fq * 4) * 4);
            const f32x4 er = {__expf(m4[0]), __expf(m4[1]), __expf(m4[2]), __expf(m4[3])};
#pragma unroll
            for (int vt = 0; vt < 8; ++vt) { const f32x4 sv = S[vt] * er;
                *(LAS v2u*)(lds + L_ST + (16 * vt + fr) * 272 + (16 * wave + fq * 4) * 2) = (v2u){pk2(sv[0], sv[1]), pk2(sv[2], sv[3])}; }
        }
        __syncthreads();
        if (FULL) {
            const int tt = wave >> 1, wh = wave & 1;
            bf16x8 Qf[4];
#pragma unroll
            for (int ks = 0; ks < 4; ++ks) Qf[ks] = *(const LAS bf16x8*)(lds + L_QT + (16 * tt + fr) * 272 + (ks * 32 + fq * 8) * 2);
#pragma unroll
            for (int s2 = 0; s2 < 2; ++s2) { const int st = 2 * wh + s2; f32x4 a = {0.f, 0.f, 0.f, 0.f};
                if (st <= tt) {
#pragma unroll
                    for (int ks = 0; ks < 4; ++ks) { const bf16x8 kf = *(const LAS bf16x8*)(lds + L_KH + (16 * st + fr) * 272 + (ks * 32 + fq * 8) * 2);
                        a = __builtin_amdgcn_mfma_f32_16x16x32_bf16(kf, Qf[ks], a, 0, 0, 0); }
                    const int t = 16 * tt + fr, s0 = 16 * st + fq * 4;
#pragma unroll
                    for (int r = 0; r < 4; ++r) a[r] = (s0 + r <= t) ? a[r] : 0.f;
                }
                *(LAS v2u*)(lds + L_P + (16 * tt + fr) * 144 + (16 * st + fq * 4) * 2) = (v2u){pk2(a[0], a[1]), pk2(a[2], a[3])}; }
            __syncthreads();
            f32x4 O[4];
#pragma unroll
            for (int j = 0; j < 4; ++j) { const int vt = 4 * wh + j; f32x4 a = {0.f, 0.f, 0.f, 0.f};
#pragma unroll
                for (int ks = 0; ks < 4; ++ks) { const bf16x8 sf = *(const LAS bf16x8*)(lds + L_ST + (16 * vt + fr) * 272 + (ks * 32 + fq * 8) * 2);
                    a = __builtin_amdgcn_mfma_f32_16x16x32_bf16(sf, Qf[ks], a, 0, 0, 0); }
#pragma unroll
                for (int k2 = 0; k2 < 2; ++k2) { const bf16x8 pf = *(const LAS bf16x8*)(lds + L_P + (16 * tt + fr) * 144 + (k2 * 32 + fq * 8) * 2);
                    const bf16x8 vf = *(const LAS bf16x8*)(lds + L_VT + (16 * vt + fr) * 144 + (k2 * 32 + fq * 8) * 2);
                    a = __builtin_amdgcn_mfma_f32_16x16x32_bf16(vf, pf, a, 0, 0, 0); }
                O[j] = a; }
            float ss = 0.f;
#pragma unroll
            for (int j = 0; j < 4; ++j) ss += (O[j][0] * O[j][0] + O[j][1] * O[j][1]) + (O[j][2] * O[j][2] + O[j][3] * O[j][3]);
            ss += __shfl_xor(ss, 16); ss += __shfl_xor(ss, 32);
            if (fq == 0) *(LAS float*)(lds + L_SS + ((16 * tt + fr) * 2 + wh) * 4) = ss;
            __syncthreads();
            const f32x2 s2 = *(const LAS f32x2*)(lds + L_SS + (16 * tt + fr) * 8);
            const float rinv = rsqrtf((s2.x + s2.y) * (1.0f / 128.0f) + EPS);
            const size_t row = row0 + 16 * tt + fr;
#pragma unroll
            for (int j = 0; j < 4; ++j) { const int col = h * 128 + 16 * (4 * wh + j) + fq * 4;
                const v2u z = *(const v2u*)(P + row * INC + C_ZA + col);
                const f32x4 y = (O[j] * rinv) * hn[j];
                *(v2u*)(Y + row * DM + col) = (v2u){pk2(y[0] * bf2f(z.x & 0xffffu), y[1] * bf2f(z.x >> 16)), pk2(y[2] * bf2f(z.y & 0xffffu), y[3] * bf2f(z.y >> 16))}; }
        }
        {
            const f32x4 dv = *(const LAS f32x4*)(lds + L_D + (16 * wave + fq * 4) * 4);
#pragma unroll
            for (int vt = 0; vt < 8; ++vt) S[vt] = S[vt] * dv;
#pragma unroll
            for (int k2 = 0; k2 < 2; ++k2) { const bf16x8 af = *(const LAS bf16x8*)(lds + L_KT + (16 * wave + fr) * 144 + (k2 * 32 + fq * 8) * 2);
#pragma unroll
                for (int vt = 0; vt < 8; ++vt) { const bf16x8 vf = *(const LAS bf16x8*)(lds + L_VT + (16 * vt + fr) * 144 + (k2 * 32 + fq * 8) * 2);
                    S[vt] = __builtin_amdgcn_mfma_f32_16x16x32_bf16(af, vf, S[vt], 0, 0, 0); } }
        }
    }
    if (!FULL) {
#pragma unroll
        for (int vt = 0; vt < 8; ++vt) *(f32x4*)(Gbuf + (size_t)item * 16384 + (size_t)(vt * 512 + tid) * 4) = S[vt];
        if (seg == 0) *(f32x2*)(Dt + (size_t)item * 128 + 2 * cp) = (f32x2){__expf(tot0), __expf(tot1)};
    }
    __syncthreads();
}
constexpr int LDS_PARAM_OFF = 131072 + 1024;
__device__ __forceinline__ void load_params(Params& q, LAS unsigned char* lds) {
    volatile LAS unsigned long long* s = (volatile LAS unsigned long long*)(lds + LDS_PARAM_OFF);
    unsigned long long v[16];
#pragma unroll
    for (int i = 0; i < 16; ++i) { const unsigned long long w = s[i]; v[i] = ((unsigned long long)(unsigned)__builtin_amdgcn_readfirstlane((int)(unsigned)(w >> 32)) << 32) | (unsigned)__builtin_amdgcn_readfirstlane((int)(unsigned)w); }
    q.x = (const float*)v[0]; q.c = (const float*)v[1]; q.w_ada = (const float*)v[2]; q.b_ada = (const float*)v[3]; q.norm_pre = (const float*)v[4]; q.norm_post = (const float*)v[5];
    q.w_in = (const float*)v[6]; q.lower_bounds = (const float*)v[7]; q.hgrn_norm = (const float*)v[8]; q.pool_w = (const float*)v[9]; q.pool_scale = (const float*)v[10];
    q.w_proj_a = (const float*)v[11]; q.w_proj_b = (const float*)v[12]; q.w_out = (const float*)v[13]; q.out = (float*)v[14]; q.ws = (unsigned char*)v[15];
}
#define LOADP(q) Params q; load_params(q, lds); unsigned char* ws = q.ws; (void)ws; int Gp = G, bx = (int)blockIdx.x, wv = wave, ln = lane, td = tid; asm volatile("" : "+s"(Gp), "+s"(bx), "+s"(wv), "+v"(ln), "+v"(td)); (void)Gp; (void)bx; (void)wv; (void)ln; (void)td
__global__ void __launch_bounds__(NWAVES * 64, 2) trunk_fwd(Params p) {
    extern __shared__ __attribute__((aligned(16))) unsigned char lds_raw[];
    cg::grid_group grid = cg::this_grid();
    LAS unsigned char* lds = (LAS unsigned char*)lds_raw;
    const int tid = threadIdx.x, lane = tid & 63, wave = __builtin_amdgcn_readfirstlane(tid >> 6), G = gridDim.x;
    if (tid == 0) { volatile LAS unsigned long long* s = (volatile LAS unsigned long long*)(lds + LDS_PARAM_OFF);
        s[0] = (unsigned long long)p.x; s[1] = (unsigned long long)p.c; s[2] = (unsigned long long)p.w_ada; s[3] = (unsigned long long)p.b_ada; s[4] = (unsigned long long)p.norm_pre; s[5] = (unsigned long long)p.norm_post;
        s[6] = (unsigned long long)p.w_in; s[7] = (unsigned long long)p.lower_bounds; s[8] = (unsigned long long)p.hgrn_norm; s[9] = (unsigned long long)p.pool_w; s[10] = (unsigned long long)p.pool_scale;
        s[11] = (unsigned long long)p.w_proj_a; s[12] = (unsigned long long)p.w_proj_b; s[13] = (unsigned long long)p.w_out; s[14] = (unsigned long long)p.out; s[15] = (unsigned long long)p.ws; }
    __syncthreads();

    { LOADP(q); phase0(q, lds, td, wv, ln, Gp, bx); }
    grid.sync();
    { LOADP(q); phase_mod(q, td, Gp, bx); }
    grid.sync();
    for (int l = 0; l < DEPTH; ++l) {
        { LOADP(q); row_pass(q, l, wv, ln, Gp, bx); }
        grid.sync();
        if (PHON(0)) {
            LOADP(q);
            pg8::Gemm g{(const bf16*)(ws + WS_H), (const bf16*)(ws + WS_WIN) + (size_t)l * INC * DM, T, INC, DM, DM, DM, 0}; pg8::StaticOrder S; S.init(T, INC, Gp, bx);
            EpiProj E{(bf16*)(ws + WS_PROJ), (float*)(ws + WS_LF), (const float*)(ws + WS_LB) + l * 1024};
            pg8::gemm_phase<EpiProj, pg8::StaticOrder, true, true>(lds, g, S, E);
        }
        grid.sync();
#if HGRN_NAIVE
        { LOADP(q);
          if (bx < 32) { if (wv == 0) hgrn_naive(q, bx, ln); }
          else pooled_pass(q, wv, ln, Gp - 32, bx - 32); }
        grid.sync();
        { LOADP(q); ya_pass(q, l, wv, ln, Gp, bx); }
#else
        { LOADP(q); for (int item = bx; item < 256; item += Gp) hgrn_chunks<false>(q, lds, l, item, td, wv, ln); pooled_pass(q, wv, ln, Gp, bx); }
        grid.sync();
        { LOADP(q); for (int item = bx; item < 256; item += Gp) hgrn_chunks<true>(q, lds, l, item, td, wv, ln); }
#endif
        if (PHON(1)) {
            LOADP(q);
            pg8::Gemm g{(const bf16*)(ws + WS_POOLED), (const bf16*)(ws + WS_WPOOL) + (size_t)l * 1024 * 256, T, 1024, 256, 1024, 256, 256}; pg8::StaticOrder S; S.init(T, 1024, Gp, bx);
            EpiGen<1> E{(bf16*)(ws + WS_Y) + 1024, DM, nullptr, 0, (const bf16*)(ws + WS_PROJ) + C_ZB, INC, q.pool_scale + l * 1024};
            pg8::gemm_phase<EpiGen<1>, pg8::StaticOrder, true, true>(lds, g, S, E);
        }
        grid.sync();
        if (PHON(2)) {
            LOADP(q);
            pg8::Gemm g{(const bf16*)(ws + WS_Y), (const bf16*)(ws + WS_WPA) + (size_t)l * DM * 1024, T, DM, 1024, DM, 1024, 0}; pg8::StaticOrder S; S.init(T, DM, Gp, bx);
            EpiGen<2> E{nullptr, 0, (float*)(ws + WS_T1), DM, (const bf16*)(ws + WS_PROJ) + C_GA, INC, nullptr};
            pg8::gemm_phase<EpiGen<2>, pg8::StaticOrder, true, true>(lds, g, S, E);
        }
        if (PHON(3)) {
            LOADP(q);
            pg8::Gemm g{(const bf16*)(ws + WS_Y) + 1024, (const bf16*)(ws + WS_WPB) + (size_t)l * DM * 1024, T, DM, 1024, DM, 1024, 0}; pg8::StaticOrder S; S.init(T, DM, Gp, bx);
            EpiGen<3> E{(bf16*)(ws + WS_MERGED), DM, (float*)(ws + WS_T1), DM, (const bf16*)(ws + WS_PROJ) + C_GB, INC, nullptr};
            pg8::gemm_phase<EpiGen<3>, pg8::StaticOrder, true, true>(lds, g, S, E);
        }
        grid.sync();
        if (PHON(4)) {
            LOADP(q);
            pg8::Gemm g{(const bf16*)(ws + WS_MERGED), (const bf16*)(ws + WS_WOUT) + (size_t)l * DM * DM, T, DM, DM, DM, DM, 0}; pg8::StaticOrder S; S.init(T, DM, Gp, bx);
            EpiGen<0> E{(bf16*)(ws + WS_OUT), DM, nullptr, 0, nullptr, 0, nullptr};
            pg8::gemm_phase<EpiGen<0>, pg8::StaticOrder, true, true>(lds, g, S, E);
        }
        grid.sync();
    }
    { LOADP(q); row_pass(q, DEPTH, wv, ln, Gp, bx); }
}

extern "C" void kernel_launch(void* const* d_in, const int* in_sizes, int n_in, void* d_out, int out_size, void* d_ws, size_t ws_size, hipStream_t stream) {
    static int grid_blocks = 0;
    if (!grid_blocks) {
        if (n_in != 14 || out_size != T * DM || ws_size < WS_END) { fprintf(stderr, "kernel_launch: unexpected shapes (n_in %d out %d ws %zu, need %zu)\n", n_in, out_size, ws_size, (size_t)WS_END); grid_blocks = -1; return; }
        int dev = 0, cus = 0, per_cu = 0;
        hipGetDevice(&dev);
        hipDeviceGetAttribute(&cus, hipDeviceAttributeMultiprocessorCount, dev);
        if (hipFuncSetAttribute((const void*)trunk_fwd, hipFuncAttributeMaxDynamicSharedMemorySize, LDS_BYTES) != hipSuccess) fprintf(stderr, "kernel_launch: hipFuncSetAttribute failed\n");
        hipOccupancyMaxActiveBlocksPerMultiprocessor(&per_cu, trunk_fwd, NWAVES * 64, LDS_BYTES);
        if (per_cu < 1) per_cu = 1;
        grid_blocks = cus * 1;
        fprintf(stderr, "kernel_launch: cus %d per_cu %d grid %d\n", cus, per_cu, grid_blocks);
    }
    if (grid_blocks <= 0) return;
    Params p{};
    p.x = (const float*)d_in[0]; p.c = (const float*)d_in[1]; p.w_ada = (const float*)d_in[2]; p.b_ada = (const float*)d_in[3]; p.norm_pre = (const float*)d_in[4]; p.norm_post = (const float*)d_in[5];
    p.w_in = (const float*)d_in[6]; p.lower_bounds = (const float*)d_in[7]; p.hgrn_norm = (const float*)d_in[8]; p.pool_w = (const float*)d_in[9]; p.pool_scale = (const float*)d_in[10];
    p.w_proj_a = (const float*)d_in[11]; p.w_proj_b = (const float*)d_in[12]; p.w_out = (const float*)d_in[13];
    p.out = (float*)d_out; p.ws = (unsigned char*)d_ws;
    void* args[] = {&p};
    hipError_t e = hipLaunchCooperativeKernel((const void*)trunk_fwd, dim3(grid_blocks), dim3(NWAVES * 64), args, LDS_BYTES, stream);
    if (e != hipSuccess) fprintf(stderr, "kernel_launch: cooperative launch failed: %s (grid %d)\n", hipGetErrorString(e), grid_blocks);
}
```

```cpp
#include <hip/hip_runtime.h>
#include <hip/hip_cooperative_groups.h>
#include <cstdio>
#include <cstdint>
namespace cg = cooperative_groups;
namespace pg8 {
#define PG8_LAS __attribute__((address_space(3)))
typedef unsigned short bf16_t;
typedef short bf16x8 __attribute__((ext_vector_type(8)));
typedef float f32x4 __attribute__((ext_vector_type(4)));
typedef unsigned u32x4 __attribute__((ext_vector_type(4)));
constexpr int BM = 256, BK = 64, HALF = 128, HTB = HALF * BK * 2  , STAGE_BYTES = 8 * HTB, NXCD = 8, WGM = 8;

__host__ __device__ __forceinline__ int lds_byte(int r, int c) { const int st = (r >> 4) * 2 + (c >> 5), rr = r & 15, cc = c & 31, ob = rr * 64 + cc * 2; return st * 1024 + (ob ^ (((ob >> 9) & 1) << 5)); }
__host__ __device__ __forceinline__ void stage_rc(int b, int& R, int& C) { const int st = b / 1024, sb = b % 1024, swz = sb ^ (((sb >> 9) & 1) << 5); R = (st >> 1) * 16 + swz / 64; C = (st & 1) * 32 + (swz % 64) / 2; }
__host__ __device__ __forceinline__ int perm32(int rho) { const int n = rho >> 4, i = rho & 15; return 8 * (i >> 2) + 4 * n + (i & 3); }

struct Unit { int pm, pn; };
struct Gemm { const bf16_t* A; const bf16_t* Bt; int M, N, K, lda, ldb, akoff, aksh; };

struct StaticOrder {
    int nM, nN, nwg, G, c;
    __host__ __device__ void init(int M, int N, int G_, int c_) { nM = M / BM; nN = N / BM; nwg = nM * nN; G = G_; c = c_; }
    __host__ __device__ bool next(int i, Unit& u) const {
        const long L = (long)i * G + c; if (L >= nwg) return false;
        int wgid = (int)L; { const int q = nwg / NXCD, r = nwg % NXCD, xcd = wgid % NXCD, off = wgid / NXCD; wgid = (xcd < r ? xcd * (q + 1) : r * (q + 1) + (xcd - r) * q) + off; }
        const int nig = WGM * nN, gid = wgid / nig, fm = gid * WGM, gsz = (nM - fm) < WGM ? (nM - fm) : WGM;
        u.pm = fm + ((wgid % nig) % gsz); u.pn = (wgid % nig) / gsz; return true;
    }
    __device__ __forceinline__ void a_ready(const Unit&) const {}
    __device__ __forceinline__ void done(const Unit&) const {}
};
__device__ __forceinline__ unsigned cvt_pk_bf16(float lo, float hi) { unsigned r; asm volatile("v_cvt_pk_bf16_f32 %0, %1, %2" : "=v"(r) : "v"(lo), "v"(hi)); return r; }
template <class Epi, class Sched, bool ALIGN_EPI = false, bool SP2 = false>
__device__ __forceinline__ void gemm_phase(PG8_LAS unsigned char* lds, const Gemm g, const Sched& S, const Epi& E, int tid_in) {
    int tid_ = tid_in; asm volatile("" : "+v"(tid_));
    const int tid = tid_, wid = __builtin_amdgcn_readfirstlane(tid >> 6), lane = tid & 63, wr = wid >> 2, wc = wid & 3, fr = lane & 15, fq = lane >> 4;
    const int K = g.K, nt = K / BK;
    unsigned voffA[2], voffB[2];
#pragma unroll
    for (int i = 0; i < 2; ++i) { int R, C; stage_rc(tid * 16 + i * 8192, R, C); const int Rb = Epi::PERM ? ((R & ~31) + perm32(R & 31)) : R;
        voffA[i] = (unsigned)(R * g.lda + C) * 2u; voffB[i] = (unsigned)(Rb * g.ldb + C) * 2u; }
    const size_t kstep = (size_t)(BK * 2);
    const size_t hstepA = (size_t)HALF * g.lda * 2, hstepB = (size_t)HALF * g.ldb * 2;
    const size_t tstepA = 2 * hstepA, tstepB = 2 * hstepB, akb = (size_t)g.akoff * 2;
    const unsigned ldsw = (unsigned)wid * 1024u;
    const int aoff = lds_byte(wr * 64 + fr, fq * 8), boff = lds_byte(wc * 32 + fr, fq * 8);
#define PG8_SA(b, h) (((b) * 2 + (h)) * HTB)
#define PG8_SB(b, h) ((4 + (b) * 2 + (h)) * HTB)
#define PG8_STAGE(bufoff, gbase, voff) do { _Pragma("unroll") for (int _i = 0; _i < 2; ++_i) \
        __builtin_amdgcn_global_load_lds((const unsigned*)((const char*)(gbase) + (voff)[_i]), (PG8_LAS unsigned*)(lds + (bufoff) + ldsw + _i * 8192), 16, 0, 0); } while (0)
#define PG8_LDA(dst, b, h) do { _Pragma("unroll") for (int m = 0; m < 4; ++m) _Pragma("unroll") for (int k = 0; k < 2; ++k) dst[m][k] = *(const PG8_LAS bf16x8*)(lds + PG8_SA(b, h) + aoff + m * 2048 + k * 1024); } while (0)
#define PG8_LDB(dst, b, h) do { _Pragma("unroll") for (int n = 0; n < 2; ++n) _Pragma("unroll") for (int k = 0; k < 2; ++k) dst[n][k] = *(const PG8_LAS bf16x8*)(lds + PG8_SB(b, h) + boff + n * 2048 + k * 1024); } while (0)
#define PG8_MMA(ai, bj, At, Bt) do { __builtin_amdgcn_s_setprio(1); _Pragma("unroll") for (int m = 0; m < 4; ++m) _Pragma("unroll") for (int n = 0; n < 2; ++n) _Pragma("unroll") for (int k = 0; k < 2; ++k) \
        acc[ai][bj][m][n] = __builtin_amdgcn_mfma_f32_16x16x32_bf16(Bt[n][k], At[m][k], acc[ai][bj][m][n], 0, 0, 0); __builtin_amdgcn_s_setprio(0); } while (0)
#define PG8_WAIT_V(n) asm volatile("s_waitcnt vmcnt(" #n ")" ::: "memory")
#define PG8_WAIT_L(n) asm volatile("s_waitcnt lgkmcnt(" #n ")" ::: "memory")
#define PG8_BAR __builtin_amdgcn_s_barrier()
#define PG8_SCHED __builtin_amdgcn_sched_barrier(0)
    Unit cur, nxt; int ui = 0;
    if (!S.next(0, cur)) return;
    f32x4 acc[2][2][4][2];
#pragma unroll
    for (int a = 0; a < 2; ++a)
#pragma unroll
        for (int b = 0; b < 2; ++b)
#pragma unroll
            for (int m = 0; m < 4; ++m)
#pragma unroll
                for (int n = 0; n < 2; ++n) acc[a][b][m][n] = (f32x4){0.f, 0.f, 0.f, 0.f};
    bf16x8 At[4][2], B0[2][2], B1[2][2];
    const char* cA = (const char*)g.A + (size_t)cur.pm * tstepA + (size_t)(cur.pn >> g.aksh) * akb; const char* cB = (const char*)g.Bt + (size_t)cur.pn * tstepB;
    S.a_ready(cur);
    if constexpr (SP2) {
        PG8_STAGE(PG8_SB(0, 0), cB, voffB); PG8_STAGE(PG8_SB(0, 1), cB + hstepB, voffB); PG8_STAGE(PG8_SA(0, 0), cA, voffA); PG8_STAGE(PG8_SA(0, 1), cA + hstepA, voffA);
        if (wr == 1) PG8_BAR;
        PG8_WAIT_V(2); PG8_BAR;
        PG8_STAGE(PG8_SB(1, 0), cB + kstep, voffB); PG8_STAGE(PG8_SA(1, 0), cA + kstep, voffA); PG8_STAGE(PG8_SB(1, 1), cB + hstepB + kstep, voffB);
        PG8_WAIT_V(6); PG8_BAR;
    } else {
        PG8_STAGE(PG8_SB(0, 0), cB, voffB); PG8_STAGE(PG8_SA(0, 0), cA, voffA); PG8_STAGE(PG8_SB(0, 1), cB + hstepB, voffB); PG8_STAGE(PG8_SA(0, 1), cA + hstepA, voffA);
        if (wr == 1) PG8_BAR;
        PG8_WAIT_V(4); PG8_BAR;
        PG8_STAGE(PG8_SB(1, 0), cB + kstep, voffB); PG8_STAGE(PG8_SA(1, 0), cA + kstep, voffA); PG8_STAGE(PG8_SB(1, 1), cB + hstepB + kstep, voffB);
        PG8_WAIT_V(6); PG8_BAR;
    }
    for (;;) {
        const bool has_next = S.next(ui + 1, nxt);
        const char* nA = has_next ? (const char*)g.A + (size_t)nxt.pm * tstepA + (size_t)(nxt.pn >> g.aksh) * akb : cA; const char* nB = has_next ? (const char*)g.Bt + (size_t)nxt.pn * tstepB : cB;
#pragma nounroll
        for (int t = 0; t < nt; t += 2) {
            const bool last = (t == nt - 2);
            const char* a1 = cA + (size_t)(t + 1) * kstep;
            const char* a2 = last ? nA : cA + (size_t)(t + 2) * kstep; const char* b2 = last ? nB : cB + (size_t)(t + 2) * kstep;
            const char* a3 = a2 + kstep; const char* b3 = b2 + kstep;
            if (last && has_next) S.a_ready(nxt);
            if constexpr (SP2) {
            PG8_LDB(B0, 0, 0); PG8_LDB(B1, 0, 1); PG8_SCHED; PG8_LDA(At, 0, 0); PG8_STAGE(PG8_SA(1, 1), a1 + hstepA, voffA);
            PG8_WAIT_V(8); PG8_WAIT_L(0); PG8_BAR; PG8_MMA(0, 0, At, B0); PG8_MMA(0, 1, At, B1); PG8_BAR; PG8_SCHED;
            PG8_LDA(At, 0, 1); PG8_STAGE(PG8_SB(0, 0), b2, voffB); PG8_STAGE(PG8_SB(0, 1), b2 + hstepB, voffB); PG8_STAGE(PG8_SA(0, 0), a2, voffA);
            PG8_WAIT_V(8); PG8_WAIT_L(0); PG8_BAR; PG8_MMA(1, 0, At, B0); PG8_MMA(1, 1, At, B1); PG8_BAR; PG8_SCHED;
            PG8_LDB(B0, 1, 0); PG8_LDB(B1, 1, 1); PG8_SCHED; PG8_LDA(At, 1, 0); PG8_STAGE(PG8_SA(0, 1), a2 + hstepA, voffA);
            PG8_WAIT_V(8); PG8_WAIT_L(0); PG8_BAR; PG8_MMA(0, 0, At, B0); PG8_MMA(0, 1, At, B1); PG8_BAR; PG8_SCHED;
            PG8_LDA(At, 1, 1); PG8_STAGE(PG8_SB(1, 0), b3, voffB); PG8_STAGE(PG8_SB(1, 1), b3 + hstepB, voffB); PG8_STAGE(PG8_SA(1, 0), a3, voffA);
            PG8_WAIT_V(8); PG8_WAIT_L(0); PG8_BAR; PG8_MMA(1, 0, At, B0); PG8_MMA(1, 1, At, B1); PG8_BAR; PG8_SCHED;
            } else {
            PG8_LDB(B0, 0, 0); PG8_SCHED; PG8_LDA(At, 0, 0); PG8_STAGE(PG8_SA(1, 1), a1 + hstepA, voffA);
            PG8_WAIT_L(8); PG8_BAR; PG8_WAIT_L(0); PG8_MMA(0, 0, At, B0); PG8_BAR; PG8_SCHED;
            PG8_LDB(B1, 0, 1); PG8_STAGE(PG8_SB(0, 0), b2, voffB);
            PG8_BAR; PG8_WAIT_L(0); PG8_MMA(0, 1, At, B1); PG8_BAR;
            PG8_LDA(At, 0, 1); PG8_STAGE(PG8_SA(0, 0), a2, voffA);
            PG8_BAR; PG8_WAIT_L(0); PG8_MMA(1, 0, At, B0); PG8_BAR; PG8_SCHED;
            PG8_STAGE(PG8_SB(0, 1), b2 + hstepB, voffB);
            PG8_WAIT_V(6); PG8_BAR; PG8_MMA(1, 1, At, B1); PG8_BAR;
            PG8_LDB(B0, 1, 0); PG8_SCHED; PG8_LDA(At, 1, 0); PG8_STAGE(PG8_SA(0, 1), a2 + hstepA, voffA);
            PG8_WAIT_L(8); PG8_BAR; PG8_WAIT_L(0); PG8_MMA(0, 0, At, B0); PG8_BAR; PG8_SCHED;
            PG8_LDB(B1, 1, 1); PG8_STAGE(PG8_SB(1, 0), b3, voffB);
            PG8_BAR; PG8_WAIT_L(0); PG8_MMA(0, 1, At, B1); PG8_BAR;
            PG8_LDA(At, 1, 1); PG8_STAGE(PG8_SA(1, 0), a3, voffA);
            PG8_BAR; PG8_WAIT_L(0); PG8_MMA(1, 0, At, B0); PG8_BAR; PG8_SCHED;
            PG8_STAGE(PG8_SB(1, 1), b3 + hstepB, voffB);
            PG8_WAIT_V(6); PG8_BAR; PG8_MMA(1, 1, At, B1); PG8_BAR;
            }
        }
        if constexpr (ALIGN_EPI) { if (wr == 0) PG8_BAR; }
        if constexpr (!Epi::AFTER_DRAIN) { E(acc, cur, wr, wc, fr, fq); S.done(cur); }
        if (!has_next) break;
        bool keep = false; if constexpr (Epi::KEEPACC) keep = E.keep_acc(cur);
        if (!keep) {
#pragma unroll
        for (int a = 0; a < 2; ++a)
#pragma unroll
            for (int b = 0; b < 2; ++b)
#pragma unroll
                for (int m = 0; m < 4; ++m)
#pragma unroll
                    for (int n = 0; n < 2; ++n) acc[a][b][m][n] = (f32x4){0.f, 0.f, 0.f, 0.f};
        }
        cur = nxt; cA = nA; cB = nB; ++ui;
        if constexpr (ALIGN_EPI) { if (wr == 1) PG8_BAR; }
    }
    PG8_WAIT_V(0);
    if constexpr (!ALIGN_EPI) { if (wr == 0) PG8_BAR; }
    PG8_BAR;
    if constexpr (Epi::AFTER_DRAIN) { E.fused(acc, cur, wr, wc, fr, fq, lds, wid, lane); S.done(cur); }
#undef PG8_SA
#undef PG8_SB
#undef PG8_STAGE
#undef PG8_LDA
#undef PG8_LDB
#undef PG8_MMA
#undef PG8_WAIT_V
#undef PG8_WAIT_L
#undef PG8_BAR
#undef PG8_SCHED
}
}

#define LAS __attribute__((address_space(3)))
#define GAS __attribute__((address_space(1)))
typedef unsigned short bf16;
typedef unsigned v4u __attribute__((ext_vector_type(4)));
typedef unsigned v2u __attribute__((ext_vector_type(2)));
typedef float f32x4 __attribute__((ext_vector_type(4)));
typedef float f32x2 __attribute__((ext_vector_type(2)));
typedef _Float16 f16x2 __attribute__((ext_vector_type(2)));
constexpr int DM = 2048, NB = 2, SEQ = 8192, DEPTH = 4, T = NB * SEQ, INC = 10240, NWAVES = 8;
constexpr int C_Q = 0, C_F = 1024, C_VA = 2048, C_ZA = 3072, C_VB = 4096, C_ZB = 5120, C_GA = 6144, C_GB = 8192;
constexpr float EPS = 1e-6f;
constexpr int LDH = DM + 64;
constexpr int LDS_BYTES = 163840;
constexpr size_t MiB = 1u << 20;
constexpr size_t WS_WIN = 0;
constexpr size_t WS_WPA = WS_WIN + 176 * MiB;
constexpr size_t WS_WPB = WS_WPA + 16 * MiB;
constexpr size_t WS_WOUT = WS_WPB + 16 * MiB;
constexpr size_t WS_WPOOL = WS_WOUT + 32 * MiB;
constexpr size_t WS_MODP = WS_WPOOL + 2 * MiB;
constexpr size_t WS_MOD = WS_MODP + 3 * MiB;
constexpr size_t WS_LB = WS_MOD + 512 * 1024;
constexpr size_t WS_BAR = WS_MOD + 768 * 1024;
constexpr size_t WS_DT = WS_BAR + 64 * 1024;
constexpr size_t WS_H = WS_MOD + 1 * MiB;
constexpr size_t WS_PROJ = WS_H + 72 * MiB;
constexpr size_t WS_LF = WS_PROJ + 320 * MiB;
constexpr size_t WS_POOLED = WS_LF + 64 * MiB;
constexpr size_t WS_Y = WS_POOLED + 32 * MiB;
constexpr size_t WS_T1 = WS_Y + 64 * MiB;
constexpr size_t WS_WVB = WS_T1;
constexpr size_t WS_MERGED = WS_T1 + 128 * MiB;
constexpr size_t WS_OUT = WS_MERGED + 64 * MiB;
constexpr size_t WS_G = WS_OUT + 64 * MiB;
constexpr size_t WS_S = WS_G + 16 * MiB;
constexpr size_t WS_GT = WS_S + 16 * MiB;
constexpr size_t WS_END = WS_GT + 128 * MiB;

__device__ __forceinline__ float bf2f(unsigned b) { return __uint_as_float(b << 16); }
__device__ __forceinline__ unsigned pk2(float lo, float hi) { return pg8::cvt_pk_bf16(lo, hi); }
__device__ __forceinline__ unsigned pkh2(float lo, float hi) { const f16x2 v = {(_Float16)lo, (_Float16)hi}; return __builtin_bit_cast(unsigned, v); }
__device__ __forceinline__ float sigm(float x) { return __builtin_amdgcn_rcpf(1.0f + __expf(-x)); }
__device__ __forceinline__ float xshfl(float v, int o, int lane) { return __int_as_float(__builtin_amdgcn_ds_bpermute((lane ^ o) << 2, __float_as_int(v))); }
__device__ __forceinline__ float wave_sum(float v, int lane) {
#pragma unroll
    for (int o = 1; o < 64; o <<= 1) v += xshfl(v, o, lane);
    return v;
}
#define LDS_WAIT() asm volatile("s_waitcnt lgkmcnt(0)" ::: "memory")

typedef pg8::f32x4 af4;
struct EpiProj {
    static constexpr bool PERM = true, AFTER_DRAIN = false, KEEPACC = false;
    bf16* P; unsigned short* LF; const float* lb; v4u* GT;
    __device__ __forceinline__ void operator()(const af4 (&acc)[2][2][4][2], const pg8::Unit& u, int wr, int wc, int fr, int fq) const {
        const int row0 = u.pm * 256 + wr * 64 + fr, colb = u.pn * 256 + wc * 32 + 8 * fq;
        const int pn = u.pn;
        const int mode = (pn < 4) ? 1 : (pn < 8) ? 3 : (pn < 12) ? 0 : (pn < 16) ? 1 : (pn < 20) ? 0 : (pn < 24) ? 1 : 2;
        if (mode == 3) {
            float lbv[2][8];
#pragma unroll
            for (int bj = 0; bj < 2; ++bj) { const f32x4 a = *(const f32x4*)(lb + colb - C_F + bj * 128), b = *(const f32x4*)(lb + colb - C_F + bj * 128 + 4);
                lbv[bj][0] = a[0]; lbv[bj][1] = a[1]; lbv[bj][2] = a[2]; lbv[bj][3] = a[3]; lbv[bj][4] = b[0]; lbv[bj][5] = b[1]; lbv[bj][6] = b[2]; lbv[bj][7] = b[3]; }
#pragma unroll
            for (int ai = 0; ai < 2; ++ai)
#pragma unroll
                for (int m = 0; m < 4; ++m) { const size_t row = (size_t)(row0 + ai * 128 + m * 16);
#pragma unroll
                    for (int bj = 0; bj < 2; ++bj) { float kk[8], lf[8];
#pragma unroll
                        for (int j = 0; j < 8; ++j) { const float a = acc[ai][bj][m][j >> 2][j & 3], l = lbv[bj][j];
                            const float sg = __builtin_amdgcn_rcpf(1.0f + __expf(-a)), sn = __builtin_amdgcn_rcpf(1.0f + __expf(a));
                            const float f = l + (1.0f - l) * sg; lf[j] = __logf(fmaxf(f, 1e-30f)); kk[j] = (1.0f - l) * sn; }
                        v4u w; w.x = pk2(kk[0], kk[1]); w.y = pk2(kk[2], kk[3]); w.z = pk2(kk[4], kk[5]); w.w = pk2(kk[6], kk[7]);
                        *(v4u*)(P + row * INC + colb + bj * 128) = w;
                        *(v4u*)(LF + row * 1024 + (colb - C_F) + bj * 128) = (v4u){pkh2(lf[0], lf[1]), pkh2(lf[2], lf[3]), pkh2(lf[4], lf[5]), pkh2(lf[6], lf[7])}; } }
        } else {
#pragma unroll
            for (int ai = 0; ai < 2; ++ai)
#pragma unroll
                for (int m = 0; m < 4; ++m) { const size_t row = (size_t)(row0 + ai * 128 + m * 16);
#pragma unroll
                    for (int bj = 0; bj < 2; ++bj) { float o[8];
#pragma unroll
                        for (int j = 0; j < 8; ++j) { const float a = acc[ai][bj][m][j >> 2][j & 3];
                            o[j] = (mode == 0) ? a : (mode == 1) ? a * sigm(a) : sigm(a); }
                        v4u w; w.x = pk2(o[0], o[1]); w.y = pk2(o[2], o[3]); w.z = pk2(o[4], o[5]); w.w = pk2(o[6], o[7]);
                        if (mode == 2) GT[((size_t)(((pn - 24) >> 3) * 512 + u.pm * 8 + ((pn - 24) & 7)) * 16 + (ai * 4 + m) * 2 + bj) * 512 + (wr * 4 + wc) * 64 + fq * 16 + fr] = w;
                        else *(v4u*)(P + row * INC + colb + bj * 128) = w; } }
        }
    }
};
template <int MODE> struct EpiGen {
    static constexpr bool PERM = true, AFTER_DRAIN = false, KEEPACC = false; static constexpr int MB = (MODE == 3) ? 2 : 4;
    bf16* O; int ldo; float* F; int ldf; const bf16* X; int ldx; const float* vec;
    __device__ __forceinline__ void operator()(const af4 (&acc)[2][2][4][2], const pg8::Unit& u, int wr, int wc, int fr, int fq) const {
        const int row0 = u.pm * 256 + wr * 64 + fr, colb = u.pn * 256 + wc * 32 + 8 * fq;
        f32x4 va[2], vb[2];
        if (MODE == 1) {
#pragma unroll
            for (int bj = 0; bj < 2; ++bj) { va[bj] = *(const f32x4*)(vec + colb + bj * 128); vb[bj] = *(const f32x4*)(vec + colb + bj * 128 + 4); } }
#pragma unroll
        for (int aim = 0; aim < 2 * (4 / MB); ++aim) { const int ai = aim / (4 / MB), mb = (aim % (4 / MB)) * MB;
            v4u xw[MB][2]; f32x4 fa[MB][2], fb[MB][2];
            if (MODE != 0) {
#pragma unroll
                for (int m = 0; m < MB; ++m)
#pragma unroll
                    for (int bj = 0; bj < 2; ++bj) xw[m][bj] = *(const v4u*)(X + (size_t)(row0 + ai * 128 + (mb + m) * 16) * ldx + colb + bj * 128); }
            if (MODE == 3) {
#pragma unroll
                for (int m = 0; m < MB; ++m)
#pragma unroll
                    for (int bj = 0; bj < 2; ++bj) { const float* fp = F + (size_t)(row0 + ai * 128 + (mb + m) * 16) * ldf + colb + bj * 128; fa[m][bj] = *(const f32x4*)fp; fb[m][bj] = *(const f32x4*)(fp + 4); } }
#pragma unroll
            for (int m = 0; m < MB; ++m) { const size_t row = (size_t)(row0 + ai * 128 + (mb + m) * 16);
#pragma unroll
                for (int bj = 0; bj < 2; ++bj) { const int col = colb + bj * 128; float o[8];
#pragma unroll
                    for (int j = 0; j < 8; ++j) o[j] = acc[ai][bj][mb + m][j >> 2][j & 3];
                    if (MODE != 0) { const v4u w4 = xw[m][bj];
                        o[0] *= bf2f(w4.x & 0xffffu); o[1] *= bf2f(w4.x >> 16); o[2] *= bf2f(w4.y & 0xffffu); o[3] *= bf2f(w4.y >> 16); o[4] *= bf2f(w4.z & 0xffffu); o[5] *= bf2f(w4.z >> 16); o[6] *= bf2f(w4.w & 0xffffu); o[7] *= bf2f(w4.w >> 16); }
                    if (MODE == 1) { o[0] *= va[bj][0]; o[1] *= va[bj][1]; o[2] *= va[bj][2]; o[3] *= va[bj][3]; o[4] *= vb[bj][0]; o[5] *= vb[bj][1]; o[6] *= vb[bj][2]; o[7] *= vb[bj][3]; }
                    if (MODE == 2) { float* fp = F + row * ldf + col; *(f32x4*)fp = (f32x4){o[0], o[1], o[2], o[3]}; *(f32x4*)(fp + 4) = (f32x4){o[4], o[5], o[6], o[7]}; }
                    else { if (MODE == 3) { o[0] += fa[m][bj][0]; o[1] += fa[m][bj][1]; o[2] += fa[m][bj][2]; o[3] += fa[m][bj][3]; o[4] += fb[m][bj][0]; o[5] += fb[m][bj][1]; o[6] += fb[m][bj][2]; o[7] += fb[m][bj][3]; }
                        v4u w; w.x = pk2(o[0], o[1]); w.y = pk2(o[2], o[3]); w.z = pk2(o[4], o[5]); w.w = pk2(o[6], o[7]);
                        *(v4u*)(O + row * ldo + col) = w; } } }
        }
    }
};
struct EpiPair {
    static constexpr bool PERM = true, AFTER_DRAIN = false, KEEPACC = true;
    bf16* O; const v4u* GT;
    __device__ __forceinline__ bool keep_acc(const pg8::Unit& u) const { return u.pn < 8; }
    __device__ __forceinline__ void operator()(af4 (&acc)[2][2][4][2], const pg8::Unit& u, int wr, int wc, int fr, int fq) const {
        const int row0 = u.pm * 256 + wr * 64 + fr, colb = (u.pn & 7) * 256 + wc * 32 + 8 * fq;
        const v4u* ga4 = GT + (size_t)(u.pm * 8 + (u.pn & 7)) * 16 * 512 + (wr * 4 + wc) * 64 + fq * 16 + fr; const v4u* gb4 = ga4 + (size_t)512 * 16 * 512;
        if (u.pn < 8) {
#pragma unroll
            for (int aim = 0; aim < 2; ++aim) { const int ai = aim, mb = 0;
                v4u xa[4][2], xb[4][2];
#pragma unroll
                for (int m = 0; m < 4; ++m)
#pragma unroll
                    for (int bj = 0; bj < 2; ++bj) { const int o = ((ai * 4 + mb + m) * 2 + bj) * 512; xb[m][bj] = gb4[o]; xa[m][bj] = ga4[o]; }
#pragma unroll
                for (int m = 0; m < 4; ++m)
#pragma unroll
                    for (int bj = 0; bj < 2; ++bj) { const unsigned wa[4] = {xa[m][bj].x, xa[m][bj].y, xa[m][bj].z, xa[m][bj].w}, wb[4] = {xb[m][bj].x, xb[m][bj].y, xb[m][bj].z, xb[m][bj].w};
#pragma unroll
                        for (int j = 0; j < 4; ++j) { const float r0 = bf2f(wa[j] & 0xffffu) * __builtin_amdgcn_rcpf(fmaxf(bf2f(wb[j] & 0xffffu), 1e-30f)), r1 = bf2f(wa[j] >> 16) * __builtin_amdgcn_rcpf(fmaxf(bf2f(wb[j] >> 16), 1e-30f));
                            acc[ai][bj][mb + m][j >> 1][(2 * j) & 3] *= r0; acc[ai][bj][mb + m][j >> 1][(2 * j + 1) & 3] *= r1; } }
            }
        } else {
#pragma unroll
            for (int ai = 0; ai < 2; ++ai) {
                v4u xb[4][2];
#pragma unroll
                for (int m = 0; m < 4; ++m)
#pragma unroll
                    for (int bj = 0; bj < 2; ++bj) xb[m][bj] = gb4[((ai * 4 + m) * 2 + bj) * 512];
#pragma unroll
                for (int m = 0; m < 4; ++m)
#pragma unroll
                    for (int bj = 0; bj < 2; ++bj) { const unsigned wb[4] = {xb[m][bj].x, xb[m][bj].y, xb[m][bj].z, xb[m][bj].w}; unsigned w[4];
#pragma unroll
                        for (int j = 0; j < 4; ++j) w[j] = pk2(acc[ai][bj][m][j >> 1][(2 * j) & 3] * fmaxf(bf2f(wb[j] & 0xffffu), 1e-30f), acc[ai][bj][m][j >> 1][(2 * j + 1) & 3] * fmaxf(bf2f(wb[j] >> 16), 1e-30f));
                        *(v4u*)(O + (size_t)(row0 + ai * 128 + m * 16) * DM + colb + bj * 128) = (v4u){w[0], w[1], w[2], w[3]}; }
            }
        }
    }
};
struct PairOrder : pg8::StaticOrder {
    __device__ __forceinline__ bool next(int i, pg8::Unit& u) const { if (!pg8::StaticOrder::next(i >> 1, u)) return false; u.pn += 8 * (i & 1); return true; }
};
struct EpiFold {
    static constexpr bool PERM = true, AFTER_DRAIN = false, KEEPACC = false;
    bf16* WINp; const float* ps;
    __device__ __forceinline__ void operator()(const af4 (&acc)[2][2][4][2], const pg8::Unit& u, int wr, int wc, int fr, int fq) const {
        const int row0 = u.pm * 256 + wr * 64 + fr, colb = u.pn * 256 + wc * 32 + 8 * fq;
        float g[2][8];
#pragma unroll
        for (int bj = 0; bj < 2; ++bj)
#pragma unroll
            for (int j = 0; j < 8; ++j) g[bj][j] = ps[colb + bj * 128 + j];
#pragma unroll
        for (int ai = 0; ai < 2; ++ai)
#pragma unroll
            for (int m = 0; m < 4; ++m) { const int k = row0 + ai * 128 + m * 16;
#pragma unroll
                for (int bj = 0; bj < 2; ++bj)
#pragma unroll
                    for (int j = 0; j < 8; ++j) { const int n = colb + bj * 128 + j;
                        WINp[((size_t)(n >> 10) * INC + C_VB + (n & 1023)) * LDH + k] = (bf16)(pk2(acc[ai][bj][m][j >> 2][j & 3] * g[bj][j], 0.f) & 0xffffu); } }
    }
};
struct Params {
    const float *x, *c, *w_ada, *b_ada, *norm_pre, *norm_post, *w_in, *lower_bounds, *hgrn_norm, *pool_w, *pool_scale, *w_proj_a, *w_proj_b, *w_out;
    float* out; unsigned char* ws;
};

struct TItem { const float* src; bf16* dst; const float* rs; int N, ldt; };
__device__ __forceinline__ TItem titem_mk(const float* W, int K, int N, bf16* WT, int ldt, int item, const float* rs = nullptr) {
    const int nblk = N / 64, kb = item / nblk, nb = item % nblk;
    TItem t; t.src = W + (size_t)(64 * kb) * N + 64 * nb; t.dst = WT + (size_t)(64 * nb) * ldt + 64 * kb; t.rs = rs ? rs + 64 * kb : nullptr; t.N = N; t.ldt = ldt; return t;
}
__device__ __forceinline__ void titem_load(const TItem& t, f32x4 (&r)[16], int lane) {
#pragma unroll
    for (int i = 0; i < 16; ++i) r[i] = *(const f32x4*)(t.src + (size_t)(4 * i + (lane >> 4)) * t.N + 4 * (lane & 15));
}
__device__ __forceinline__ void phase0(const Params& p, LAS unsigned char* lds, int tid, int wave, int lane, int G, int bidx) {
    LAS float* cact = (LAS float*)lds;
    LAS float* scr = (LAS float*)(lds + 16384 + wave * 16640);
    for (int i = tid; i < NB * DM; i += NWAVES * 64) { const float v = p.c[i]; cact[i] = v * sigm(v); }
    __syncthreads();
    const int gw = bidx * NWAVES + wave, NGW = G * NWAVES;
    float* modp = (float*)(p.ws + WS_MODP);
    for (int it = gw; it < DEPTH * 24 * 16; it += NGW) {
        const int ks = it & 15, cgp = (it >> 4) % 24, l = it / (16 * 24);
        const int col0 = cgp * 256 + lane * 4, k0 = ks * 128;
        const float* w = p.w_ada + ((size_t)l * DM + k0) * 6144 + col0;
        f32x4 a0 = {0.f, 0.f, 0.f, 0.f}, a1 = {0.f, 0.f, 0.f, 0.f};
#pragma unroll 16
        for (int k = 0; k < 128; ++k) { const f32x4 wv = *(const f32x4*)(w + (size_t)k * 6144); const float c0 = cact[k0 + k], c1 = cact[DM + k0 + k]; a0 += wv * c0; a1 += wv * c1; }
        *(f32x4*)(modp + ((size_t)(ks * DEPTH + l) * 2 + 0) * 6144 + col0) = a0;
        *(f32x4*)(modp + ((size_t)(ks * DEPTH + l) * 2 + 1) * 6144 + col0) = a1;
    }
    constexpr int I_IN = 32 * 160, I_PA = 16 * 32, I_OUT = 32 * 32, I_POOL = 4 * 16, I_L = I_IN + 2 * I_PA + I_OUT + I_POOL;
    bf16* WIN = (bf16*)(p.ws + WS_WIN); bf16* WPA = (bf16*)(p.ws + WS_WPA); bf16* WPB = (bf16*)(p.ws + WS_WPB); bf16* WOUT = (bf16*)(p.ws + WS_WOUT); bf16* WPOOL = (bf16*)(p.ws + WS_WPOOL);
    auto mk = [&](int it) -> TItem {
        const int l = it / I_L; int r = it % I_L;
        if (r < I_IN) return titem_mk(p.w_in + (size_t)l * DM * INC, DM, INC, WIN + (size_t)l * INC * LDH, LDH, r); r -= I_IN;
        if (r < I_PA) return titem_mk(p.w_proj_a + (size_t)l * 1024 * DM, 1024, DM, WPA + (size_t)l * 4096 * 1024, 1024, r, p.hgrn_norm + l * 1024); r -= I_PA;
        if (r < I_PA) return titem_mk(p.w_proj_b + (size_t)l * 1024 * DM, 1024, DM, WPA + ((size_t)l * 4096 + 2048) * 1024, 1024, r); r -= I_PA;
        if (r < I_OUT) return titem_mk(p.w_out + (size_t)l * DM * DM, DM, DM, WOUT + (size_t)l * DM * DM, DM, r); r -= I_OUT;
        const int g = r / 16; return titem_mk(p.pool_w + (size_t)(l * 4 + g) * 65536, 256, 256, WPOOL + (size_t)(l * 1024 + g * 256) * 256, 256, r % 16);
    };
    if (gw < DEPTH * I_L) {
        f32x4 rg[16]; TItem cur = mk(gw); titem_load(cur, rg, lane);
        for (int it = gw; it < DEPTH * I_L; it += NGW) {
#pragma unroll
            for (int i = 0; i < 16; ++i) { LAS float* w = scr + (4 * i + (lane >> 4)) * 65 + 4 * (lane & 15); const float g = cur.rs ? cur.rs[4 * i + (lane >> 4)] : 1.0f; w[0] = rg[i][0] * g; w[1] = rg[i][1] * g; w[2] = rg[i][2] * g; w[3] = rg[i][3] * g; }
            TItem nxt = cur;
            if (it + NGW < DEPTH * I_L) { nxt = mk(it + NGW); titem_load(nxt, rg, lane); }
            LDS_WAIT(); asm volatile("" ::: "memory");
            const int c = lane & 7;
#pragma unroll
            for (int j = 0; j < 8; ++j) { const int n = (lane >> 3) + 8 * j; const LAS float* sp = scr + (8 * c) * 65 + n;
                v4u o; o.x = pk2(sp[0 * 65], sp[1 * 65]); o.y = pk2(sp[2 * 65], sp[3 * 65]); o.z = pk2(sp[4 * 65], sp[5 * 65]); o.w = pk2(sp[6 * 65], sp[7 * 65]);
                *(v4u*)(cur.dst + (size_t)n * cur.ldt + 8 * c) = o; }
            LDS_WAIT(); asm volatile("" ::: "memory");
            cur = nxt;
        }
    }
    {
        bf16* WVB = (bf16*)(p.ws + WS_WVB);
        for (int i = bidx * (NWAVES * 64) + tid; i < DEPTH * DM * 128; i += G * NWAVES * 64) { const int c8 = i & 127, k = (i >> 7) & (DM - 1), l = i >> 18;
            const float* src = p.w_in + ((size_t)l * DM + k) * INC + C_VB + c8 * 8; const f32x4 a = *(const f32x4*)src, b = *(const f32x4*)(src + 4);
            *(v4u*)(WVB + (size_t)k * 4096 + l * 1024 + c8 * 8) = (v4u){pk2(a[0], a[1]), pk2(a[2], a[3]), pk2(b[0], b[1]), pk2(b[2], b[3])}; }
    }
    if (bidx == 0) {
        float* lbo = (float*)(p.ws + WS_LB);
        for (int i = tid; i < 1024; i += NWAVES * 64) {
            const float v0 = p.lower_bounds[i], v1 = p.lower_bounds[1024 + i], v2 = p.lower_bounds[2048 + i], v3 = p.lower_bounds[3072 + i];
            const float mx = fmaxf(fmaxf(v0, v1), fmaxf(v2, v3));
            const float e0 = expf(v0 - mx), e1 = expf(v1 - mx), e2 = expf(v2 - mx), e3 = expf(v3 - mx), inv = 1.0f / (e0 + e1 + e2 + e3);
            lbo[i] = 0.f; lbo[1024 + i] = e1 * inv; lbo[2048 + i] = (e1 + e2) * inv; lbo[3072 + i] = (e1 + e2 + e3) * inv;
        }
    }
}
__device__ __forceinline__ void phase_mod(const Params& p, int tid, int G, int bidx) {
    const float* modp = (const float*)(p.ws + WS_MODP); float* mod = (float*)(p.ws + WS_MOD);
    for (int i = bidx * (NWAVES * 64) + tid; i < DEPTH * 2 * 6144; i += G * NWAVES * 64) {
        const int l = i / (2 * 6144), cidx = i % 6144;
        float s = p.b_ada[l * 6144 + cidx];
#pragma unroll
        for (int ks = 0; ks < 16; ++ks) s += modp[(size_t)ks * (DEPTH * 2 * 6144) + i];
        mod[i] = s;
    }
}
template <bool HAS_OUT, bool XB16> __device__ __forceinline__ void rp_load(f32x4 (&xf)[8], v2u (&xh)[8], v2u (&ow)[8], const float* xsrc, const bf16* XB, const bf16* OUT, int r, int lane) {
#pragma unroll
    for (int j = 0; j < 8; ++j) { if (XB16) xh[j] = *(const v2u*)(XB + (size_t)r * DM + j * 256 + lane * 4); else xf[j] = *(const f32x4*)(xsrc + (size_t)r * DM + j * 256 + lane * 4);
        if (HAS_OUT) ow[j] = *(const v2u*)(OUT + (size_t)r * DM + j * 256 + lane * 4); }
}
template <int RM> __device__ __forceinline__ void rp_row(const f32x4 (&xf)[8], const v2u (&xh)[8], const v2u (&ow)[8], float* xout, bf16* XB, bf16* H, LAS unsigned char* lds, int r, int lane) {
    constexpr bool HAS_OUT = RM >= 1, HAS_H = RM <= 2, XB16 = RM >= 2;
    const LAS float* vec = (const LAS float*)lds + (r >> 13) * 3 * DM;
    f32x4 x[8];
#pragma unroll
    for (int j = 0; j < 8; ++j) x[j] = XB16 ? (f32x4){bf2f(xh[j].x & 0xffffu), bf2f(xh[j].x >> 16), bf2f(xh[j].y & 0xffffu), bf2f(xh[j].y >> 16)} : xf[j];
    if (HAS_OUT) {
        f32x4 o[8]; float ss = 0.f;
#pragma unroll
        for (int j = 0; j < 8; ++j) { o[j] = (f32x4){bf2f(ow[j].x & 0xffffu), bf2f(ow[j].x >> 16), bf2f(ow[j].y & 0xffffu), bf2f(ow[j].y >> 16)};
            ss += (o[j][0] * o[j][0] + o[j][1] * o[j][1]) + (o[j][2] * o[j][2] + o[j][3] * o[j][3]); }
        const float rinv = rsqrtf(wave_sum(ss, lane) * (1.0f / DM) + EPS);
#pragma unroll
        for (int j = 0; j < 8; ++j) { x[j] = x[j] + *(const LAS f32x4*)(vec + j * 256 + lane * 4) * (o[j] * rinv);
            if (RM == 3) *(f32x4*)(xout + (size_t)r * DM + j * 256 + lane * 4) = x[j];
            else *(v2u*)(XB + (size_t)r * DM + j * 256 + lane * 4) = (v2u){pk2(x[j][0], x[j][1]), pk2(x[j][2], x[j][3])}; }
    }
    if (HAS_H) {
        float ss = 0.f;
#pragma unroll
        for (int j = 0; j < 8; ++j) ss += (x[j][0] * x[j][0] + x[j][1] * x[j][1]) + (x[j][2] * x[j][2] + x[j][3] * x[j][3]);
        const float rinv = rsqrtf(wave_sum(ss, lane) * (1.0f / DM) + EPS);
#pragma unroll
        for (int j = 0; j < 8; ++j) { const f32x4 h = (x[j] * rinv) * *(const LAS f32x4*)(vec + DM + j * 256 + lane * 4) + *(const LAS f32x4*)(vec + 2 * DM + j * 256 + lane * 4);
            v2u w; w.x = pk2(h[0], h[1]); w.y = pk2(h[2], h[3]);
            *(v2u*)(H + (size_t)r * LDH + j * 256 + lane * 4) = w; }
    }
}
template <int RM  >
__device__ __forceinline__ void row_pass(const Params& p, LAS unsigned char* lds, int l, int tid, int wave, int lane, int G, int bidx) {
    constexpr bool HAS_OUT = RM >= 1, HAS_H = RM <= 2, XB16 = RM >= 2;
    const float* mod = (const float*)(p.ws + WS_MOD); const bf16* OUT = (const bf16*)(p.ws + WS_OUT); bf16* H = (bf16*)(p.ws + WS_H); bf16* XB = (bf16*)(p.ws + WS_T1 + 32 * MiB);
    const int gw = bidx * NWAVES + wave, NGW = G * NWAVES;
    {
        LAS float* vec = (LAS float*)lds;
        for (int i = tid; i < NB * DM; i += NWAVES * 64) { const int b = i >> 11, c = i & (DM - 1);
            if (HAS_OUT) vec[(b * 3 + 0) * DM + c] = mod[(size_t)((l - 1) * 2 + b) * 6144 + 4096 + c] * p.norm_post[(l - 1) * DM + c];
            if (HAS_H) { vec[(b * 3 + 1) * DM + c] = p.norm_pre[l * DM + c] * (1.0f + mod[(size_t)(l * 2 + b) * 6144 + 2048 + c]); vec[(b * 3 + 2) * DM + c] = mod[(size_t)(l * 2 + b) * 6144 + c]; } }
        __syncthreads();
    }
    const int n = (gw < T) ? (T - gw + NGW - 1) / NGW : 0;
    f32x4 fa[8], fb[8], fc[8]; v2u ha[8], hb[8], hc[8], oa[8], ob[8], oc[8];
    if (n > 0) rp_load<HAS_OUT, XB16>(fa, ha, oa, p.x, XB, OUT, gw, lane);
    if (n > 1) rp_load<HAS_OUT, XB16>(fb, hb, ob, p.x, XB, OUT, gw + NGW, lane);
    for (int i = 0; i < n; i += 3) {
        if (i + 2 < n) rp_load<HAS_OUT, XB16>(fc, hc, oc, p.x, XB, OUT, gw + (i + 2) * NGW, lane);
        rp_row<RM>(fa, ha, oa, p.out, XB, H, lds, gw + i * NGW, lane);
        if (i + 1 < n) { if (i + 3 < n) rp_load<HAS_OUT, XB16>(fa, ha, oa, p.x, XB, OUT, gw + (i + 3) * NGW, lane);
            rp_row<RM>(fb, hb, ob, p.out, XB, H, lds, gw + (i + 1) * NGW, lane); }
        if (i + 2 < n) { if (i + 4 < n) rp_load<HAS_OUT, XB16>(fb, hb, ob, p.x, XB, OUT, gw + (i + 4) * NGW, lane);
            rp_row<RM>(fc, hc, oc, p.out, XB, H, lds, gw + (i + 2) * NGW, lane); }
    }
    __syncthreads();
}
template <int WMAX> __device__ __forceinline__ void pooled_half(const bf16* P, bf16* PO, int r, int t, int c) {
    const int w = 2 << (c >> 8), n = (t + 1 < w) ? t + 1 : w;
    v4u q[WMAX];
#pragma unroll
    for (int i = 0; i < WMAX; ++i) { const int back = (i < n) ? i : 0; q[i] = *(const v4u*)(P + (size_t)(r - back) * INC + C_VB + c); }
    float s[8], v0[8];
#pragma unroll
    for (int j = 0; j < 8; ++j) s[j] = 0.f;
#pragma unroll
    for (int i = 0; i < WMAX; ++i) { const float e[8] = {bf2f(q[i].x & 0xffffu), bf2f(q[i].x >> 16), bf2f(q[i].y & 0xffffu), bf2f(q[i].y >> 16), bf2f(q[i].z & 0xffffu), bf2f(q[i].z >> 16), bf2f(q[i].w & 0xffffu), bf2f(q[i].w >> 16)};
        const float keep = (i < n) ? 1.0f : 0.0f;
#pragma unroll
        for (int j = 0; j < 8; ++j) { s[j] += keep * e[j]; if (i == 0) v0[j] = e[j]; } }
    const float inv = 1.0f / (float)n;
    v4u o; o.x = pk2(s[0] * inv - v0[0], s[1] * inv - v0[1]); o.y = pk2(s[2] * inv - v0[2], s[3] * inv - v0[3]); o.z = pk2(s[4] * inv - v0[4], s[5] * inv - v0[5]); o.w = pk2(s[6] * inv - v0[6], s[7] * inv - v0[7]);
    *(v4u*)(PO + (size_t)r * 1024 + c) = o;
}
__device__ __forceinline__ void pooled_pass(const Params& p, int wave, int lane, int G, int bidx) {
    const bf16* P = (const bf16*)(p.ws + WS_PROJ); bf16* PO = (bf16*)(p.ws + WS_POOLED);
    const int gw = bidx * NWAVES + wave, NGW = G * NWAVES;
    for (int r = gw; r < T; r += NGW) { const int t = r & (SEQ - 1);
        pooled_half<4>(P, PO, r, t, lane * 8);
        pooled_half<16>(P, PO, r, t, 512 + lane * 8); }
}
template <int WMAX> __device__ __forceinline__ void yb_half(const bf16* P, bf16* Y, const float* ps, int r, int t, int c) {
    const int w = 2 << (c >> 8), n = (t + 1 < w) ? t + 1 : w;
    v4u q[WMAX];
#pragma unroll
    for (int i = 0; i < WMAX; ++i) { const int back = (i < n) ? i : 0; q[i] = *(const v4u*)(P + (size_t)(r - back) * INC + C_VB + c); }
    const v4u zq = *(const v4u*)(P + (size_t)r * INC + C_ZB + c);
    float s[8], v0[8];
#pragma unroll
    for (int j = 0; j < 8; ++j) s[j] = 0.f;
#pragma unroll
    for (int i = 0; i < WMAX; ++i) { const float e[8] = {bf2f(q[i].x & 0xffffu), bf2f(q[i].x >> 16), bf2f(q[i].y & 0xffffu), bf2f(q[i].y >> 16), bf2f(q[i].z & 0xffffu), bf2f(q[i].z >> 16), bf2f(q[i].w & 0xffffu), bf2f(q[i].w >> 16)};
        const float keep = (i < n) ? 1.0f : 0.0f;
#pragma unroll
        for (int j = 0; j < 8; ++j) { s[j] += keep * e[j]; if (i == 0) v0[j] = e[j]; } }
    const float inv = 1.0f / (float)n;
    const float z[8] = {bf2f(zq.x & 0xffffu), bf2f(zq.x >> 16), bf2f(zq.y & 0xffffu), bf2f(zq.y >> 16), bf2f(zq.z & 0xffffu), bf2f(zq.z >> 16), bf2f(zq.w & 0xffffu), bf2f(zq.w >> 16)};
    float y[8];
#pragma unroll
    for (int j = 0; j < 8; ++j) y[j] = (s[j] * inv - v0[j]) * z[j];
    *(v4u*)(Y + (size_t)r * DM + 1024 + c) = (v4u){pk2(y[0], y[1]), pk2(y[2], y[3]), pk2(y[4], y[5]), pk2(y[6], y[7])};
}
template <int WMAX, int NO> __device__ __forceinline__ void yb_block(const bf16* P, bf16* Y, int R0, int c) {
    constexpr int NR = WMAX - 1 + NO;
    const int w = 2 << (c >> 8), t0 = R0 & (SEQ - 1), seq0 = R0 - t0;
    const float big = (w == WMAX) ? 1.0f : 0.0f;
    v4u q[NR], zq[NO];
#pragma unroll
    for (int k = 0; k < NR; ++k) { const int row = R0 - (WMAX - 1) + k; const bool ok = row >= seq0;
        const v4u v = *(const v4u*)(P + (size_t)(ok ? row : seq0) * INC + C_VB + c);
        q[k] = ok ? v : (v4u){0u, 0u, 0u, 0u}; }
#pragma unroll
    for (int i = 0; i < NO; ++i) zq[i] = *(const v4u*)(P + (size_t)(R0 + i) * INC + C_ZB + c);
    float s[NO][8];
#pragma unroll
    for (int i = 0; i < NO; ++i)
#pragma unroll
        for (int j = 0; j < 8; ++j) s[i][j] = 0.f;
#pragma unroll
    for (int k = 0; k < NR; ++k) { const v4u r = q[k];
        const float e[8] = {bf2f(r.x & 0xffffu), bf2f(r.x >> 16), bf2f(r.y & 0xffffu), bf2f(r.y >> 16), bf2f(r.z & 0xffffu), bf2f(r.z >> 16), bf2f(r.w & 0xffffu), bf2f(r.w >> 16)};
        float eb[8];
#pragma unroll
        for (int j = 0; j < 8; ++j) eb[j] = e[j] * big;
#pragma unroll
        for (int i = 0; i < NO; ++i) { const int jj = WMAX - 1 + i - k;
            if (jj >= 0 && jj < WMAX) {
#pragma unroll
                for (int j = 0; j < 8; ++j) s[i][j] += (jj < WMAX / 2) ? e[j] : eb[j]; } } }
#pragma unroll
    for (int i = 0; i < NO; ++i) { const int t = t0 + i, n = (t + 1 < w) ? t + 1 : w; const float inv = 1.0f / (float)n; const v4u r = q[WMAX - 1 + i], z4 = zq[i];
        const float v0[8] = {bf2f(r.x & 0xffffu), bf2f(r.x >> 16), bf2f(r.y & 0xffffu), bf2f(r.y >> 16), bf2f(r.z & 0xffffu), bf2f(r.z >> 16), bf2f(r.w & 0xffffu), bf2f(r.w >> 16)};
        const float z[8] = {bf2f(z4.x & 0xffffu), bf2f(z4.x >> 16), bf2f(z4.y & 0xffffu), bf2f(z4.y >> 16), bf2f(z4.z & 0xffffu), bf2f(z4.z >> 16), bf2f(z4.w & 0xffffu), bf2f(z4.w >> 16)};
        float y[8];
#pragma unroll
        for (int j = 0; j < 8; ++j) y[j] = (s[i][j] * inv - v0[j]) * z[j];
        *(v4u*)(Y + (size_t)(R0 + i) * DM + 1024 + c) = (v4u){pk2(y[0], y[1]), pk2(y[2], y[3]), pk2(y[4], y[5]), pk2(y[6], y[7])}; }
}
template <int WMAX, int NO> __device__ __forceinline__ void yb_block_lds(const bf16* P, bf16* Y, LAS unsigned char* lds, int R0, int lrow, int c) {
    constexpr int NR = WMAX - 1 + NO;
    const int w = 2 << (c >> 8), t0 = R0 & (SEQ - 1);
    const float big = (w == WMAX) ? 1.0f : 0.0f;
    v4u zq[NO];
#pragma unroll
    for (int i = 0; i < NO; ++i) zq[i] = *(const v4u*)(P + (size_t)(R0 + i) * INC + C_ZB + c);
    float s[NO][8];
#pragma unroll
    for (int i = 0; i < NO; ++i)
#pragma unroll
        for (int j = 0; j < 8; ++j) s[i][j] = 0.f;
    const LAS unsigned char* base = lds + (lrow - (WMAX - 1)) * 2048 + c * 2;
#pragma unroll
    for (int k = 0; k < NR; ++k) { const v4u r = *(const LAS v4u*)(base + k * 2048);
        const float e[8] = {bf2f(r.x & 0xffffu), bf2f(r.x >> 16), bf2f(r.y & 0xffffu), bf2f(r.y >> 16), bf2f(r.z & 0xffffu), bf2f(r.z >> 16), bf2f(r.w & 0xffffu), bf2f(r.w >> 16)};
        float eb[8];
#pragma unroll
        for (int j = 0; j < 8; ++j) eb[j] = e[j] * big;
#pragma unroll
        for (int i = 0; i < NO; ++i) { const int jj = WMAX - 1 + i - k;
            if (jj >= 0 && jj < WMAX) {
#pragma unroll
                for (int j = 0; j < 8; ++j) s[i][j] += (jj < WMAX / 2) ? e[j] : eb[j]; } } }
#pragma unroll
    for (int i = 0; i < NO; ++i) { const int t = t0 + i, n = (t + 1 < w) ? t + 1 : w; const float inv = 1.0f / (float)n; const v4u r = *(const LAS v4u*)(base + (WMAX - 1 + i) * 2048), z4 = zq[i];
        const float v0[8] = {bf2f(r.x & 0xffffu), bf2f(r.x >> 16), bf2f(r.y & 0xffffu), bf2f(r.y >> 16), bf2f(r.z & 0xffffu), bf2f(r.z >> 16), bf2f(r.w & 0xffffu), bf2f(r.w >> 16)};
        const float z[8] = {bf2f(z4.x & 0xffffu), bf2f(z4.x >> 16), bf2f(z4.y & 0xffffu), bf2f(z4.y >> 16), bf2f(z4.z & 0xffffu), bf2f(z4.z >> 16), bf2f(z4.w & 0xffffu), bf2f(z4.w >> 16)};
        float y[8];
#pragma unroll
        for (int j = 0; j < 8; ++j) y[j] = (s[i][j] * inv - v0[j]) * z[j];
        *(v4u*)(Y + (size_t)(R0 + i) * DM + 1024 + c) = (v4u){pk2(y[0], y[1]), pk2(y[2], y[3]), pk2(y[4], y[5]), pk2(y[6], y[7])}; }
}
__device__ __forceinline__ void yb_pass(const Params& p, LAS unsigned char* lds, int l, int tid, int wave, int lane, int G, int bidx) {
    const bf16* P = (const bf16*)(p.ws + WS_PROJ); bf16* Y = (bf16*)(p.ws + WS_Y);
    for (int RB = bidx * 32; RB < T; RB += G * 32) {
        const int seq0 = RB - (RB & (SEQ - 1));
#pragma unroll
        for (int ps = 0; ps < 12; ++ps) { const int lr = ps * 4 + (tid >> 7);
            if (lr < 47) { const int row = RB - 15 + lr; const bool ok = row >= seq0;
                const v4u v = *(const v4u*)(P + (size_t)(ok ? row : seq0) * INC + C_VB + (tid & 127) * 8);
                *(LAS v4u*)(lds + lr * 2048 + (tid & 127) * 16) = ok ? v : (v4u){0u, 0u, 0u, 0u}; } }
        __syncthreads();
        const int R0 = RB + 4 * wave, lrow = 15 + 4 * wave;
        yb_block_lds<4, 4>(P, Y, lds, R0, lrow, lane * 8);
        yb_block_lds<16, 4>(P, Y, lds, R0, lrow, 512 + lane * 8);
        __syncthreads();
    }
}
__device__ __forceinline__ void hgrn_naive(const Params& p, int job, int lane) {
    const bf16* P = (const bf16*)(p.ws + WS_PROJ); const _Float16* LF = (const _Float16*)(p.ws + WS_LF); float* OR = (float*)(p.ws + WS_T1);
    const int b = job >> 4, h = (job >> 1) & 7, vh = job & 1;
    float S[128];
#pragma unroll
    for (int k = 0; k < 128; ++k) S[k] = 0.f;
    const size_t r0 = (size_t)b * SEQ;
    const bf16* pr = P + r0 * INC + h * 128; const _Float16* lr = LF + r0 * 1024 + h * 128;
    float nv = bf2f(pr[C_VA + vh * 64 + lane]), nq0 = bf2f(pr[C_Q + lane]), nq1 = bf2f(pr[C_Q + 64 + lane]), nk0 = bf2f(pr[C_F + lane]), nk1 = bf2f(pr[C_F + 64 + lane]), nl0 = (float)lr[lane], nl1 = (float)lr[64 + lane];
    for (int t = 0; t < SEQ; ++t) {
        const float v = nv, q0 = nq0, q1 = nq1, k0 = nk0, k1 = nk1, f0 = __expf(nl0), f1 = __expf(nl1);
        if (t + 1 < SEQ) { const bf16* pn = pr + (size_t)(t + 1) * INC; const _Float16* ln = lr + (size_t)(t + 1) * 1024;
            nv = bf2f(pn[C_VA + vh * 64 + lane]); nq0 = bf2f(pn[C_Q + lane]); nq1 = bf2f(pn[C_Q + 64 + lane]); nk0 = bf2f(pn[C_F + lane]); nk1 = bf2f(pn[C_F + 64 + lane]); nl0 = (float)ln[lane]; nl1 = (float)ln[64 + lane]; }
        float o = 0.f;
#pragma unroll
        for (int k = 0; k < 64; ++k) {
            const float fk = __int_as_float(__builtin_amdgcn_readlane(__float_as_int(f0), k)), kk = __int_as_float(__builtin_amdgcn_readlane(__float_as_int(k0), k)), qk = __int_as_float(__builtin_amdgcn_readlane(__float_as_int(q0), k));
            S[k] = fmaf(fk, S[k], kk * v); o = fmaf(S[k], qk, o); if ((k & 7) == 7) __builtin_amdgcn_sched_barrier(0); }
#pragma unroll
        for (int k = 0; k < 64; ++k) {
            const float fk = __int_as_float(__builtin_amdgcn_readlane(__float_as_int(f1), k)), kk = __int_as_float(__builtin_amdgcn_readlane(__float_as_int(k1), k)), qk = __int_as_float(__builtin_amdgcn_readlane(__float_as_int(q1), k));
            S[64 + k] = fmaf(fk, S[64 + k], kk * v); o = fmaf(S[64 + k], qk, o); if ((k & 7) == 7) __builtin_amdgcn_sched_barrier(0); }
        OR[(r0 + t) * 1024 + h * 128 + vh * 64 + lane] = o;
    }
}
__device__ __forceinline__ void ya_pass(const Params& p, int l, int wave, int lane, int G, int bidx) {
    const bf16* P = (const bf16*)(p.ws + WS_PROJ); const float* OR = (const float*)(p.ws + WS_T1); bf16* Y = (bf16*)(p.ws + WS_Y);
    const int gw = bidx * NWAVES + wave, NGW = G * NWAVES;
    for (int r = gw; r < T; r += NGW) {
#pragma unroll
        for (int h = 0; h < 8; ++h) { const int c = h * 128 + lane * 2;
            const float o0 = OR[(size_t)r * 1024 + c], o1 = OR[(size_t)r * 1024 + c + 1];
            const float rinv = rsqrtf(wave_sum(o0 * o0 + o1 * o1, lane) * (1.0f / 128.0f) + EPS);
            const unsigned z = *(const unsigned*)(P + (size_t)r * INC + C_ZA + c);
            const float g0 = p.hgrn_norm[l * 1024 + c], g1 = p.hgrn_norm[l * 1024 + c + 1];
            *(unsigned*)(Y + (size_t)r * DM + c) = pk2((o0 * rinv) * g0 * bf2f(z & 0xffffu), (o1 * rinv) * g1 * bf2f(z >> 16)); }
    }
}

#ifndef PHMASK
#define PHMASK 0xff
#endif
#define PHON(n) (((PHMASK) >> (n)) & 1)
#ifndef FOLD
#define FOLD 1
#endif
#ifndef HGRN_NAIVE
#define HGRN_NAIVE 0
#endif
typedef short bf16x8 __attribute__((ext_vector_type(8)));
constexpr int L_QT = 0, L_KH = 17408, L_KT = 34816, L_VT = 53248, L_ST = 71680, L_P = 106496, L_SEG = 115712, L_D = 119808, L_SS = 120320;
template <bool FULL>
__device__ __forceinline__ void hgrn_chunks(const Params& p, LAS unsigned char* lds, int l, int item, int tid, int wave, int lane) {
    const bf16* P = (const bf16*)(p.ws + WS_PROJ); const unsigned short* LF = (const unsigned short*)(p.ws + WS_LF); float* Gbuf = (float*)(p.ws + WS_G); float* Dt = (float*)(p.ws + WS_DT); const float* Sin = (const float*)(p.ws + WS_S); bf16* Y = (bf16*)(p.ws + WS_Y);
    const int sc = item & 15, h = (item >> 4) & 7, b = item >> 7;
    if (!FULL && sc == 15) return;
    const int cp = lane, seg = wave;
    const int fr = lane & 15, fq = lane >> 4;
    f32x4 S[8];
#pragma unroll
    for (int vt = 0; vt < 8; ++vt) S[vt] = (f32x4){0.f, 0.f, 0.f, 0.f};
    if (FULL && sc > 0) {
#pragma unroll
        for (int vt = 0; vt < 8; ++vt) S[vt] = *(const f32x4*)(Sin + (size_t)item * 16384 + (unsigned)(vt * 2048 + tid * 4));
    }
    float tot0 = 0.f, tot1 = 0.f;
    const size_t rowsc = (size_t)b * SEQ + (size_t)sc * 512;
    constexpr int PF = 2;
    unsigned lfr[PF][8], kwr[PF][8], vwr[PF][8], qwr[PF][8];
#define HG_LOAD(cc, st) do { const size_t rb_ = rowsc + (size_t)(cc) * 64 + seg * 8; _Pragma("unroll") for (int i = 0; i < 8; ++i) { \
            lfr[st][i] = *(const unsigned*)(LF + (rb_ + i) * 1024 + h * 128 + 2 * cp); \
            const bf16* pr = P + (rb_ + i) * INC + h * 128 + 2 * cp; \
            kwr[st][i] = *(const unsigned*)(pr + C_F); vwr[st][i] = *(const unsigned*)(pr + C_VA); if (FULL) qwr[st][i] = *(const unsigned*)(pr + C_Q); } \
        } while (0)
    HG_LOAD(0, 0);
    if (PF == 2) HG_LOAD(1, 1);
    for (int c2 = 0; c2 < 8; c2 += PF) {
#pragma unroll
    for (int u = 0; u < PF; ++u) { const int c = c2 + u;
        int lz = lane; asm volatile("" : "+v"(lz));
        const int cp = lz, fr = lz & 15, fq = lz >> 4;
        const size_t row0 = rowsc + c * 64;
        float b0[8], b1[8]; unsigned kw[8], vw[8], qw[8];
#pragma unroll
        for (int i = 0; i < 8; ++i) { const f16x2 f2 = __builtin_bit_cast(f16x2, lfr[u][i]); b0[i] = (float)f2.x; b1[i] = (float)f2.y; kw[i] = kwr[u][i]; vw[i] = vwr[u][i]; if (FULL) qw[i] = qwr[u][i]; }
#pragma unroll
        for (int i = 1; i < 8; ++i) { b0[i] += b0[i - 1]; b1[i] += b1[i - 1]; }
        *(LAS f32x2*)(lds + L_SEG + (seg * 128 + 2 * cp) * 4) = (f32x2){b0[7], b1[7]};
        __syncthreads();
        float off0 = 0.f, off1 = 0.f, mid0 = 0.f, mid1 = 0.f, t0 = 0.f, t1 = 0.f;
#pragma unroll
        for (int s = 0; s < 8; ++s) { const f32x2 st = *(const LAS f32x2*)(lds + L_SEG + (s * 128 + 2 * cp) * 4);
            if (s == seg) { off0 = t0; off1 = t1; } if (s == 4) { mid0 = t0; mid1 = t1; } t0 += st.x; t1 += st.y; }
        tot0 += t0; tot1 += t1;
        {
            unsigned kt0[4], kt1[4], vt0[4], vt1[4];
#pragma unroll
            for (int i = 0; i < 8; i += 2) {
                float k0[2], k1[2], v0[2], v1[2];
#pragma unroll
                for (int u = 0; u < 2; ++u) { const int ii = i + u; const float bt0 = off0 + b0[ii], bt1 = off1 + b1[ii];
                    const float kk0 = bf2f(kw[ii] & 0xffffu), kk1 = bf2f(kw[ii] >> 16);
                    k0[u] = kk0 * __expf(t0 - bt0); k1[u] = kk1 * __expf(t1 - bt1); v0[u] = bf2f(vw[ii] & 0xffffu); v1[u] = bf2f(vw[ii] >> 16);
                    if (FULL) { const float e0 = __expf(bt0 - mid0), e1 = __expf(bt1 - mid1), r0 = __expf(mid0 - bt0), r1 = __expf(mid1 - bt1);
                        *(LAS unsigned*)(lds + L_QT + (seg * 8 + ii) * 272 + cp * 4) = pk2(bf2f(qw[ii] & 0xffffu) * e0, bf2f(qw[ii] >> 16) * e1);
                        *(LAS unsigned*)(lds + L_KH + (seg * 8 + ii) * 272 + cp * 4) = pk2(kk0 * r0, kk1 * r1); } }
                kt0[i >> 1] = pk2(k0[0], k0[1]); kt1[i >> 1] = pk2(k1[0], k1[1]); vt0[i >> 1] = pk2(v0[0], v0[1]); vt1[i >> 1] = pk2(v1[0], v1[1]); }
            *(LAS v4u*)(lds + L_KT + (2 * cp) * 144 + seg * 16) = (v4u){kt0[0], kt0[1], kt0[2], kt0[3]};
            *(LAS v4u*)(lds + L_KT + (2 * cp + 1) * 144 + seg * 16) = (v4u){kt1[0], kt1[1], kt1[2], kt1[3]};
            *(LAS v4u*)(lds + L_VT + (2 * cp) * 144 + seg * 16) = (v4u){vt0[0], vt0[1], vt0[2], vt0[3]};
            *(LAS v4u*)(lds + L_VT + (2 * cp + 1) * 144 + seg * 16) = (v4u){vt1[0], vt1[1], vt1[2], vt1[3]};
            if (seg == 0) *(LAS f32x2*)(lds + L_D + 2 * cp * 4) = (f32x2){__expf(t0), __expf(t1)};
        }
        if (c + PF < 8) HG_LOAD(c + PF, u);
        if (FULL) {
            f32x4 m4 = {0.f, 0.f, 0.f, 0.f};
#pragma unroll
            for (int s = 0; s < 4; ++s) m4 += *(const LAS f32x4*)(lds + L_SEG + (s * 128 + 16 * wave + fq * 4) * 4);
            const f32x4 er = {__expf(m4[0]), __expf(m4[1]), __expf(m4[2]), __expf(m4[3])};
#pragma unroll
            for (int vt = 0; vt < 8; ++vt) { const f32x4 sv = S[vt] * er;
                *(LAS v2u*)(lds + L_ST + (16 * vt + fr) * 272 + (16 * wave + fq * 4) * 2) = (v2u){pk2(sv[0], sv[1]), pk2(sv[2], sv[3])}; }
        }
        __syncthreads();
        if (FULL) {
            const int tt = wave >> 1, wh = wave & 1;
            v2u zc[4];
#pragma unroll
            for (int j = 0; j < 4; ++j) { zc[j] = *(const v2u*)(P + (row0 + 16 * tt + fr) * INC + C_ZA + h * 128 + 16 * (4 * wh + j) + fq * 4);
 }
            bf16x8 Qf[4];
#pragma unroll
            for (int ks = 0; ks < 4; ++ks) Qf[ks] = *(const LAS bf16x8*)(lds + L_QT + (16 * tt + fr) * 272 + (ks * 32 + fq * 8) * 2);
            {
                bf16x8 Kf[2][4]; f32x4 a2[2] = {{0.f, 0.f, 0.f, 0.f}, {0.f, 0.f, 0.f, 0.f}};
#pragma unroll
                for (int s2 = 0; s2 < 2; ++s2) if (2 * wh + s2 <= tt) {
#pragma unroll
                    for (int ks = 0; ks < 4; ++ks) Kf[s2][ks] = *(const LAS bf16x8*)(lds + L_KH + (16 * (2 * wh + s2) + fr) * 272 + (ks * 32 + fq * 8) * 2); }
#pragma unroll
                for (int ks = 0; ks < 4; ++ks)
#pragma unroll
                    for (int s2 = 0; s2 < 2; ++s2) if (2 * wh + s2 <= tt) a2[s2] = __builtin_amdgcn_mfma_f32_16x16x32_bf16(Kf[s2][ks], Qf[ks], a2[s2], 0, 0, 0);
#pragma unroll
                for (int s2 = 0; s2 < 2; ++s2) { const int st = 2 * wh + s2; f32x4 a = a2[s2];
                    const int t = 16 * tt + fr, s0 = 16 * st + fq * 4;
#pragma unroll
                    for (int r = 0; r < 4; ++r) a[r] = (st <= tt && s0 + r <= t) ? a[r] : 0.f;
                    *(LAS v2u*)(lds + L_P + (16 * tt + fr) * 144 + (16 * st + fq * 4) * 2) = (v2u){pk2(a[0], a[1]), pk2(a[2], a[3])}; }
            }
            __syncthreads();
            f32x4 O[4] = {{0.f, 0.f, 0.f, 0.f}, {0.f, 0.f, 0.f, 0.f}, {0.f, 0.f, 0.f, 0.f}, {0.f, 0.f, 0.f, 0.f}};
#pragma unroll
            for (int kh = 0; kh < 2; ++kh) {
                bf16x8 sf[2][4];
#pragma unroll
                for (int k1 = 0; k1 < 2; ++k1)
#pragma unroll
                    for (int j = 0; j < 4; ++j) sf[k1][j] = *(const LAS bf16x8*)(lds + L_ST + (16 * (4 * wh + j) + fr) * 272 + ((2 * kh + k1) * 32 + fq * 8) * 2);
#pragma unroll
                for (int k1 = 0; k1 < 2; ++k1)
#pragma unroll
                    for (int j = 0; j < 4; ++j) O[j] = __builtin_amdgcn_mfma_f32_16x16x32_bf16(sf[k1][j], Qf[2 * kh + k1], O[j], 0, 0, 0); }
            {
                bf16x8 pf[2], vf[2][4];
#pragma unroll
                for (int k2 = 0; k2 < 2; ++k2) { pf[k2] = *(const LAS bf16x8*)(lds + L_P + (16 * tt + fr) * 144 + (k2 * 32 + fq * 8) * 2);
#pragma unroll
                    for (int j = 0; j < 4; ++j) vf[k2][j] = *(const LAS bf16x8*)(lds + L_VT + (16 * (4 * wh + j) + fr) * 144 + (k2 * 32 + fq * 8) * 2); }
#pragma unroll
                for (int k2 = 0; k2 < 2; ++k2)
#pragma unroll
                    for (int j = 0; j < 4; ++j) O[j] = __builtin_amdgcn_mfma_f32_16x16x32_bf16(vf[k2][j], pf[k2], O[j], 0, 0, 0); }
            float ss = 0.f;
#pragma unroll
            for (int j = 0; j < 4; ++j) ss += (O[j][0] * O[j][0] + O[j][1] * O[j][1]) + (O[j][2] * O[j][2] + O[j][3] * O[j][3]);
            ss += xshfl(ss, 16, lz); ss += xshfl(ss, 32, lz);
            if (fq == 0) *(LAS float*)(lds + L_SS + ((16 * tt + fr) * 2 + wh) * 4) = ss;
            __syncthreads();
            const f32x2 s2 = *(const LAS f32x2*)(lds + L_SS + (16 * tt + fr) * 8);
            const float rinv = rsqrtf((s2.x + s2.y) * (1.0f / 128.0f) + EPS);
            const size_t row = row0 + 16 * tt + fr;
#pragma unroll
            for (int j = 0; j < 4; ++j) { const int col = h * 128 + 16 * (4 * wh + j) + fq * 4;
                const v2u z = zc[j];
                const f32x4 y = O[j] * rinv;
                *(v2u*)(Y + row * DM + col) = (v2u){pk2(y[0] * bf2f(z.x & 0xffffu), y[1] * bf2f(z.x >> 16)), pk2(y[2] * bf2f(z.y & 0xffffu), y[3] * bf2f(z.y >> 16))}; }
        }
        {
            const f32x4 dv = *(const LAS f32x4*)(lds + L_D + (16 * wave + fq * 4) * 4);
#pragma unroll
            for (int vt = 0; vt < 8; ++vt) S[vt] = S[vt] * dv;
#pragma unroll
            for (int k2 = 0; k2 < 2; ++k2) { bf16x8 vf[8];
                const bf16x8 af = *(const LAS bf16x8*)(lds + L_KT + (16 * wave + fr) * 144 + (k2 * 32 + fq * 8) * 2);
#pragma unroll
                for (int vt = 0; vt < 8; ++vt) vf[vt] = *(const LAS bf16x8*)(lds + L_VT + (16 * vt + fr) * 144 + (k2 * 32 + fq * 8) * 2);
#pragma unroll
                for (int vt = 0; vt < 8; ++vt) S[vt] = __builtin_amdgcn_mfma_f32_16x16x32_bf16(af, vf[vt], S[vt], 0, 0, 0); }
        }
    }
    }
#undef HG_LOAD
    if (!FULL) {
#pragma unroll
        for (int vt = 0; vt < 8; ++vt) *(f32x4*)(Gbuf + (size_t)item * 16384 + (unsigned)(vt * 2048 + tid * 4)) = S[vt];
        if (seg == 0) *(f32x2*)(Dt + (size_t)item * 128 + 2 * cp) = (f32x2){__expf(tot0), __expf(tot1)};
    }
    __syncthreads();
}
#define RLX_AGENT __ATOMIC_RELAXED, __HIP_MEMORY_SCOPE_AGENT
#define XB_TMO      128
#define XB_XCNT(j)  (256  + 64 * (j))
#define XB_XSUB(j)  (1280 + 64 * (j))
#define XB_XGEN(j)  (2304 + 64 * (j))
#define XB_TOP      3328
#define XB_TOPGEN   3392
#define XCD_BAR_WORDS 3456
#define XB_SPIN_CAP (1u << 18)

__device__ __forceinline__ unsigned xb_ld(unsigned* p)              { return __hip_atomic_load(p, __ATOMIC_RELAXED, __HIP_MEMORY_SCOPE_AGENT); }
__device__ __forceinline__ unsigned xb_add(unsigned* p, unsigned v) { return __hip_atomic_fetch_add(p, v, __ATOMIC_RELAXED, __HIP_MEMORY_SCOPE_AGENT); }
__device__ __forceinline__ unsigned xb_xcc_id() { return (unsigned)__builtin_amdgcn_s_getreg((3 << 11) | 20) & 0xFu; }
#define XB_SPIN(cond, bar) do { unsigned _sp = 0; while (cond) { __builtin_amdgcn_s_sleep(1); \
    if ((++_sp & 255u) == 0u) { if (xb_ld(&(bar)[XB_TMO])) break; if (_sp > XB_SPIN_CAP) { atomicAdd(&(bar)[XB_TMO], 1u); break; } } } } while (0)

struct XcdBarrier {
    unsigned* bar; unsigned x;
    volatile LAS unsigned* st;
};

__device__ __forceinline__ XcdBarrier xcd_barrier_post(unsigned* bar, volatile LAS unsigned* st) {
    XcdBarrier b; b.bar = bar; b.x = xb_xcc_id(); b.st = st;
    if (threadIdx.x == 0) (void)xb_add(&bar[XB_XCNT(b.x)], 1u);
    return b;
}
__device__ __forceinline__ void xcd_barrier_complete(unsigned* bar, unsigned x, unsigned& nloc, unsigned& nx) {
    const unsigned G = gridDim.x * gridDim.y * gridDim.z;
    unsigned sum, cnt, mine, sp = 0u;
    for (;;) {
        sum = 0u; cnt = 0u; mine = 0u;
#pragma unroll
        for (unsigned j = 0; j < 16; ++j) { const unsigned c = xb_ld(&bar[XB_XCNT(j)]); sum += c; cnt += (c > 0u) ? 1u : 0u; mine = (j == x) ? c : mine; }
        if (sum == G) break;
        __builtin_amdgcn_s_sleep(1);
        if ((++sp & 255u) == 0u) { if (xb_ld(&bar[XB_TMO])) break; if (sp > XB_SPIN_CAP) { atomicAdd(&bar[XB_TMO], 1u); break; } }
    }
    nloc = mine > 0u ? mine : 1u; nx = cnt > 0u ? cnt : 1u;
}

__device__ __forceinline__ void xcd_barrier(const XcdBarrier& b, bool is_t0) {
    asm volatile("s_waitcnt vmcnt(0)" ::: "memory");
    __syncthreads();
    if (is_t0) {
        unsigned* bar = b.bar;
        __builtin_amdgcn_s_waitcnt(0);
        unsigned nloc = b.st[0], nx = b.st[1];
        if (nloc == 0u) { xcd_barrier_complete(bar, b.x, nloc, nx); b.st[0] = nloc; b.st[1] = nx; }
        const unsigned old = xb_add(&bar[XB_XSUB(b.x)], 1u);
        const unsigned gen = old / nloc;
        if (old + 1u == (gen + 1u) * nloc) {
            __builtin_amdgcn_fence(__ATOMIC_RELEASE, "agent");
            asm volatile("s_waitcnt vmcnt(0)" ::: "memory");
            const unsigned og = xb_add(&bar[XB_TOP], 1u);
            const unsigned tg = og / nx;
            if (og + 1u == (tg + 1u) * nx) xb_add(&bar[XB_TOPGEN], 1u);
            else XB_SPIN(xb_ld(&bar[XB_TOPGEN]) == tg, bar);
            __builtin_amdgcn_fence(__ATOMIC_ACQUIRE, "agent");
            xb_add(&bar[XB_XGEN(b.x)], 1u);
            asm volatile("s_waitcnt vmcnt(0)" ::: "memory");
        } else {
            XB_SPIN(xb_ld(&bar[XB_XGEN(b.x)]) == gen, bar);
            __builtin_amdgcn_fence(__ATOMIC_ACQUIRE, "agent");
            asm volatile("s_waitcnt vmcnt(0)" ::: "memory");
        }
    }
    __syncthreads();
}

__device__ __forceinline__ void hgrn_scan(const Params& p, int tid, int bidx) {
    const float* Gbuf = (const float*)(p.ws + WS_G); const float* Dt = (const float*)(p.ws + WS_DT); float* Sin = (float*)(p.ws + WS_S);
    const int u = bidx * (NWAVES * 64) + tid;
    if (u >= 16 * 4096) return;
    const int bh = u >> 12, e4 = u & 4095, t_ = e4 & 511, k0 = 16 * (t_ >> 6) + ((t_ & 63) >> 4) * 4;
    f32x4 g[15], d[15];
#pragma unroll
    for (int sc = 0; sc < 15; ++sc) { g[sc] = *(const f32x4*)(Gbuf + (size_t)(bh * 16 + sc) * 16384 + (size_t)e4 * 4); d[sc] = *(const f32x4*)(Dt + (size_t)(bh * 16 + sc) * 128 + k0); }
    f32x4 S = {0.f, 0.f, 0.f, 0.f};
#pragma unroll
    for (int sc = 0; sc < 15; ++sc) { S = d[sc] * S + g[sc]; *(f32x4*)(Sin + (size_t)(bh * 16 + sc + 1) * 16384 + (size_t)e4 * 4) = S; }
}
constexpr int LDS_PARAM_OFF = 163840 - 1024;
__device__ __forceinline__ void load_params(Params& q, LAS unsigned char* lds) {
    unsigned pbase = LDS_PARAM_OFF; asm volatile("" : "+v"(pbase));
    volatile LAS unsigned long long* s = (volatile LAS unsigned long long*)(lds + pbase);
    unsigned long long v[16];
#pragma unroll
    for (int i = 0; i < 16; ++i) { const unsigned long long w = s[i]; v[i] = ((unsigned long long)(unsigned)__builtin_amdgcn_readfirstlane((int)(unsigned)(w >> 32)) << 32) | (unsigned)__builtin_amdgcn_readfirstlane((int)(unsigned)w); }
    q.x = (const float*)(const GAS float*)v[0]; q.c = (const float*)(const GAS float*)v[1]; q.w_ada = (const float*)(const GAS float*)v[2]; q.b_ada = (const float*)(const GAS float*)v[3]; q.norm_pre = (const float*)(const GAS float*)v[4]; q.norm_post = (const float*)(const GAS float*)v[5];
    q.w_in = (const float*)(const GAS float*)v[6]; q.lower_bounds = (const float*)(const GAS float*)v[7]; q.hgrn_norm = (const float*)(const GAS float*)v[8]; q.pool_w = (const float*)(const GAS float*)v[9]; q.pool_scale = (const float*)(const GAS float*)v[10];
    q.w_proj_a = (const float*)(const GAS float*)v[11]; q.w_proj_b = (const float*)(const GAS float*)v[12]; q.w_out = (const float*)(const GAS float*)v[13]; q.out = (float*)(GAS float*)v[14]; q.ws = (unsigned char*)(GAS unsigned char*)v[15];
}
#ifndef PROBE_SET
#define PROBE_SET 0
#endif
#ifndef DUP
#define DUP 0
#endif
#ifndef PROBE_A
#define PROBE_A 3
#endif
#ifndef PROBE_B
#define PROBE_B 4
#endif
#define SLOT(id) ((id) == PROBE_A ? 0 : (id) == PROBE_B ? 1 : -1)
#define TSTAMP(slot) do { if (PROBE_SET) { if (tid == 0) { volatile LAS unsigned long long* tw = (volatile LAS unsigned long long*)(lds + LDS_PARAM_OFF + 256); const unsigned long long now = __builtin_amdgcn_s_memrealtime(); if ((slot) >= 0) tw[(slot)] += now - tw[2]; tw[2] = now; } } } while (0)
#define LOADP(q) Params q; load_params(q, lds); unsigned char* ws = q.ws; (void)ws; int Gp = G, bx = (int)blockIdx.x, wv = wave; asm volatile("" : "+s"(Gp), "+s"(bx), "+s"(wv)); int ln = (int)__builtin_amdgcn_mbcnt_hi(~0u, __builtin_amdgcn_mbcnt_lo(~0u, 0u)); asm volatile("" : "+v"(ln)); const int td = wv * 64 + ln; (void)Gp; (void)bx; (void)wv; (void)ln; (void)td
__global__ void __launch_bounds__(NWAVES * 64, 2) trunk_fwd(Params p) {
    extern __shared__ __attribute__((aligned(16))) unsigned char lds_raw[];
    cg::grid_group grid = cg::this_grid();
#define XSYNC1() do { LOADP(qb); XcdBarrier xb_; xb_.bar = (unsigned*)(ws + WS_BAR); xb_.x = xb_xcc_id(); xb_.st = (volatile LAS unsigned*)(lds + LDS_PARAM_OFF + 512); xcd_barrier(xb_, td == 0); } while (0)
#define GSYNC() do { XSYNC1(); if ((DUP >> 5) & 1) XSYNC1(); } while (0)
    LAS unsigned char* lds = (LAS unsigned char*)lds_raw;
    const int tid = threadIdx.x, lane = tid & 63, wave = __builtin_amdgcn_readfirstlane(tid >> 6), G = gridDim.x;
    if (tid == 0) { volatile LAS unsigned long long* s = (volatile LAS unsigned long long*)(lds + LDS_PARAM_OFF);
        s[0] = (unsigned long long)p.x; s[1] = (unsigned long long)p.c; s[2] = (unsigned long long)p.w_ada; s[3] = (unsigned long long)p.b_ada; s[4] = (unsigned long long)p.norm_pre; s[5] = (unsigned long long)p.norm_post;
        s[6] = (unsigned long long)p.w_in; s[7] = (unsigned long long)p.lower_bounds; s[8] = (unsigned long long)p.hgrn_norm; s[9] = (unsigned long long)p.pool_w; s[10] = (unsigned long long)p.pool_scale;
        s[11] = (unsigned long long)p.w_proj_a; s[12] = (unsigned long long)p.w_proj_b; s[13] = (unsigned long long)p.w_out; s[14] = (unsigned long long)p.out; s[15] = (unsigned long long)p.ws; }
    if (tid == 0) { volatile LAS unsigned* st = (volatile LAS unsigned*)(lds + LDS_PARAM_OFF + 512); st[0] = 0u; st[1] = 0u; }
    if (PROBE_SET && tid == 0) { volatile LAS unsigned long long* tw = (volatile LAS unsigned long long*)(lds + LDS_PARAM_OFF + 256); tw[0] = 0; tw[1] = 0; tw[2] = 0; }
    __syncthreads();
    TSTAMP(-1);

    for (int rep = 0; rep < 1 + (DUP & 1); ++rep) { LOADP(q); phase0(q, lds, td, wv, ln, Gp, bx); __syncthreads(); }
    { LOADP(q); if (bx == 0) for (int i = td; i < XCD_BAR_WORDS; i += NWAVES * 64) __hip_atomic_store((unsigned*)(ws + WS_BAR) + i, 0u, RLX_AGENT); }
    grid.sync();
    { LOADP(q); (void)xcd_barrier_post((unsigned*)(ws + WS_BAR), (volatile LAS unsigned*)(lds + LDS_PARAM_OFF + 512)); }
    { LOADP(q); phase_mod(q, td, Gp, bx); }
#if FOLD
    {
        LOADP(q);
        pg8::Gemm g{(const bf16*)(ws + WS_WVB), (const bf16*)(ws + WS_WPOOL), DM, 4096, 256, 4096, 256, 256, 0}; pg8::StaticOrder S; S.init(DM, 4096, Gp, bx);
        EpiFold E{(bf16*)(ws + WS_WIN), q.pool_scale};
        pg8::gemm_phase<EpiFold, pg8::StaticOrder, true, true>(lds, g, S, E, td);
    }
#endif
    GSYNC();
    TSTAMP(SLOT(0));
    for (int l = 0; l < DEPTH; ++l) {
        for (int rep = 0; rep < 1 + (((DUP >> 2) & 1) && l <= 1); ++rep) { LOADP(q); if (l == 0) row_pass<0>(q, lds, l, td, wv, ln, Gp, bx); else if (l == 1) row_pass<1>(q, lds, l, td, wv, ln, Gp, bx); else row_pass<2>(q, lds, l, td, wv, ln, Gp, bx); }
        GSYNC();
        TSTAMP(SLOT(1));
        if ((DUP >> 6) & 1) {
            LOADP(q);
            pg8::Gemm g{(const bf16*)(ws + WS_H), (const bf16*)(ws + WS_WIN) + (size_t)l * INC * LDH, T, INC, DM, LDH, LDH, 0, 0}; pg8::StaticOrder S; S.init(T, INC, Gp, bx);
            EpiGen<0> E{(bf16*)(ws + WS_PROJ), INC, nullptr, 0, nullptr, 0, nullptr};
            pg8::gemm_phase<EpiGen<0>, pg8::StaticOrder, true, true>(lds, g, S, E, td);
            GSYNC();
        }
        for (int rep = 0; rep < 1 + ((DUP >> 3) & 1); ++rep) {
            LOADP(q);
            pg8::Gemm g{(const bf16*)(ws + WS_H), (const bf16*)(ws + WS_WIN) + (size_t)l * INC * LDH, T, INC, DM, LDH, LDH, 0, 0}; pg8::StaticOrder S; S.init(T, INC, Gp, bx);
            EpiProj E{(bf16*)(ws + WS_PROJ), (unsigned short*)(ws + WS_LF), (const float*)(ws + WS_LB) + l * 1024, (v4u*)(ws + WS_GT)};
            pg8::gemm_phase<EpiProj, pg8::StaticOrder, true, true>(lds, g, S, E, td);
        }
        GSYNC();
        TSTAMP(SLOT(2));
#if HGRN_NAIVE
        { LOADP(q);
          if (bx < 32) { if (wv == 0) hgrn_naive(q, bx, ln); }
          else pooled_pass(q, wv, ln, Gp - 32, bx - 32); }
        GSYNC();
        { LOADP(q); ya_pass(q, l, wv, ln, Gp, bx); }
#else
        for (int rep = 0; rep < 1 + ((DUP >> 1) & 1); ++rep) {
        if (rep) GSYNC();
        { LOADP(q); for (int rep = 0; rep < 1 + ((DUP >> 8) & 1); ++rep) for (int item = bx; item < 256; item += Gp) hgrn_chunks<false>(q, lds, l, item, td, wv, ln);
          for (int rep = 0; rep < 1 + ((DUP >> 7) & 1); ++rep) { if (FOLD) yb_pass(q, lds, l, td, wv, ln, Gp, bx); else pooled_pass(q, wv, ln, Gp, bx); } }
        GSYNC();
        { LOADP(q); hgrn_scan(q, td, bx); }
        GSYNC();
        TSTAMP(SLOT(3));
        { LOADP(q); for (int rep = 0; rep < 1 + ((DUP >> 9) & 1); ++rep) for (int item = bx; item < 256; item += Gp) hgrn_chunks<true>(q, lds, l, item, td, wv, ln); }
        }
        TSTAMP(SLOT(4));
#endif
        for (int rep = 0; rep < (FOLD ? 0 : 1 + ((DUP >> 10) & 1)); ++rep) {
            LOADP(q);
            pg8::Gemm g{(const bf16*)(ws + WS_POOLED), (const bf16*)(ws + WS_WPOOL) + (size_t)l * 1024 * 256, T, 1024, 256, 1024, 256, 256, 0}; pg8::StaticOrder S; S.init(T, 1024, Gp, bx);
            EpiGen<1> E{(bf16*)(ws + WS_Y) + 1024, DM, nullptr, 0, (const bf16*)(ws + WS_PROJ) + C_ZB, INC, q.pool_scale + l * 1024};
            pg8::gemm_phase<EpiGen<1>, pg8::StaticOrder, true, true>(lds, g, S, E, td);
        }
        GSYNC();
        TSTAMP(SLOT(5));
        for (int rep = 0; rep < 1 + ((DUP >> 4) & 1); ++rep) {
        if (rep) GSYNC();
        {
            LOADP(q);
            pg8::Gemm g{(const bf16*)(ws + WS_Y), (const bf16*)(ws + WS_WPA) + (size_t)l * 4096 * 1024, T, 2 * DM, 1024, DM, 1024, 1024, 3}; PairOrder S; S.init(T, DM, Gp, bx);
            EpiPair E{(bf16*)(ws + WS_MERGED), (const v4u*)(ws + WS_GT)};
            pg8::gemm_phase<EpiPair, PairOrder, true, true>(lds, g, S, E, td);
        }
        GSYNC();
        TSTAMP(SLOT(6));
        if (PHON(4)) {
            LOADP(q);
            pg8::Gemm g{(const bf16*)(ws + WS_MERGED), (const bf16*)(ws + WS_WOUT) + (size_t)l * DM * DM, T, DM, DM, DM, DM, 0, 0}; pg8::StaticOrder S; S.init(T, DM, Gp, bx);
            EpiGen<0> E{(bf16*)(ws + WS_OUT), DM, nullptr, 0, nullptr, 0, nullptr};
            pg8::gemm_phase<EpiGen<0>, pg8::StaticOrder, true, true>(lds, g, S, E, td);
        }
        }
        GSYNC();
        TSTAMP(SLOT(7));
    }
    { LOADP(q); row_pass<3>(q, lds, DEPTH, td, wv, ln, Gp, bx); }
#if PROBE_SET
    GSYNC();
    TSTAMP(SLOT(1));
    __syncthreads();
    if (blockIdx.x == 0) { LOADP(q); volatile LAS unsigned long long* tw = (volatile LAS unsigned long long*)(lds + LDS_PARAM_OFF + 256);
        const float ta = (float)tw[0] * 0.01f, tb = (float)tw[1] * 0.01f;
        for (int i = td; i < 512 * DM; i += NWAVES * 64) q.out[i] *= 1.0f + tb * (1.0f / 300.0f);
        __syncthreads();
        if (td == 0) q.out[0] += ta * 0.25f; }
#endif
}

extern "C" void kernel_launch(void* const* d_in, const int* in_sizes, int n_in, void* d_out, int out_size, void* d_ws, size_t ws_size, hipStream_t stream) {
    static int grid_blocks = 0;
    if (!grid_blocks) {
        if (n_in != 14 || out_size != T * DM || ws_size < WS_END) { fprintf(stderr, "kernel_launch: unexpected shapes (n_in %d out %d ws %zu, need %zu)\n", n_in, out_size, ws_size, (size_t)WS_END); grid_blocks = -1; return; }
        int dev = 0, cus = 0, per_cu = 0;
        hipGetDevice(&dev);
        hipDeviceGetAttribute(&cus, hipDeviceAttributeMultiprocessorCount, dev);
        if (hipFuncSetAttribute((const void*)trunk_fwd, hipFuncAttributeMaxDynamicSharedMemorySize, LDS_BYTES) != hipSuccess) fprintf(stderr, "kernel_launch: hipFuncSetAttribute failed\n");
        hipOccupancyMaxActiveBlocksPerMultiprocessor(&per_cu, trunk_fwd, NWAVES * 64, LDS_BYTES);
        if (per_cu < 1) per_cu = 1;
        grid_blocks = cus * 1;
        fprintf(stderr, "kernel_launch: cus %d per_cu %d grid %d\n", cus, per_cu, grid_blocks);
    }
    if (grid_blocks <= 0) return;
    Params p{};
    p.x = (const float*)d_in[0]; p.c = (const float*)d_in[1]; p.w_ada = (const float*)d_in[2]; p.b_ada = (const float*)d_in[3]; p.norm_pre = (const float*)d_in[4]; p.norm_post = (const float*)d_in[5];
    p.w_in = (const float*)d_in[6]; p.lower_bounds = (const float*)d_in[7]; p.hgrn_norm = (const float*)d_in[8]; p.pool_w = (const float*)d_in[9]; p.pool_scale = (const float*)d_in[10];
    p.w_proj_a = (const float*)d_in[11]; p.w_proj_b = (const float*)d_in[12]; p.w_out = (const float*)d_in[13];
    p.out = (float*)d_out; p.ws = (unsigned char*)d_ws;
    void* args[] = {&p};
    hipError_t e = hipLaunchCooperativeKernel((const void*)trunk_fwd, dim3(grid_blocks), dim3(NWAVES * 64), args, LDS_BYTES, stream);
    if (e != hipSuccess) fprintf(stderr, "kernel_launch: cooperative launch failed: %s (grid %d)\n", hipGetErrorString(e), grid_blocks);
}
```

```cpp
#include <hip/hip_runtime.h>
#include <hip/hip_cooperative_groups.h>
#include <cstdio>
#include <cstdint>
namespace cg = cooperative_groups;
namespace pg8 {
#define PG8_LAS __attribute__((address_space(3)))
typedef unsigned short bf16_t;
typedef short bf16x8 __attribute__((ext_vector_type(8)));
typedef float f32x4 __attribute__((ext_vector_type(4)));
typedef unsigned u32x4 __attribute__((ext_vector_type(4)));
constexpr int BM = 256, BK = 64, HALF = 128, HTB = HALF * BK * 2  , STAGE_BYTES = 8 * HTB, NXCD = 8, WGM = 8;

__host__ __device__ __forceinline__ int lds_byte(int r, int c) { const int st = (r >> 4) * 2 + (c >> 5), rr = r & 15, cc = c & 31, ob = rr * 64 + cc * 2; return st * 1024 + (ob ^ (((ob >> 9) & 1) << 5)); }
__host__ __device__ __forceinline__ void stage_rc(int b, int& R, int& C) { const int st = b / 1024, sb = b % 1024, swz = sb ^ (((sb >> 9) & 1) << 5); R = (st >> 1) * 16 + swz / 64; C = (st & 1) * 32 + (swz % 64) / 2; }
__host__ __device__ __forceinline__ int perm32(int rho) { const int n = rho >> 4, i = rho & 15; return 8 * (i >> 2) + 4 * n + (i & 3); }

struct Unit { int pm, pn; };
struct Gemm { const bf16_t* A; const bf16_t* Bt; int M, N, K, lda, ldb, akoff, aksh; };

struct StaticOrder {
    int nM, nN, nwg, G, c;
    __host__ __device__ void init(int M, int N, int G_, int c_) { nM = M / BM; nN = N / BM; nwg = nM * nN; G = G_; c = c_; }
    __host__ __device__ bool next(int i, Unit& u) const {
        const long L = (long)i * G + c; if (L >= nwg) return false;
        int wgid = (int)L; { const int q = nwg / NXCD, r = nwg % NXCD, xcd = wgid % NXCD, off = wgid / NXCD; wgid = (xcd < r ? xcd * (q + 1) : r * (q + 1) + (xcd - r) * q) + off; }
        const int nig = WGM * nN, gid = wgid / nig, fm = gid * WGM, gsz = (nM - fm) < WGM ? (nM - fm) : WGM;
        u.pm = fm + ((wgid % nig) % gsz); u.pn = (wgid % nig) / gsz; return true;
    }
    __device__ __forceinline__ void a_ready(const Unit&) const {}
    __device__ __forceinline__ void done(const Unit&) const {}
};
__device__ __forceinline__ unsigned cvt_pk_bf16(float lo, float hi) { unsigned r; asm volatile("v_cvt_pk_bf16_f32 %0, %1, %2" : "=v"(r) : "v"(lo), "v"(hi)); return r; }
template <class Epi, class Sched, bool ALIGN_EPI = false, bool SP2 = false>
__device__ __forceinline__ void gemm_phase(PG8_LAS unsigned char* lds, const Gemm g, const Sched& S, const Epi& E, int tid_in) {
    int tid_ = tid_in; asm volatile("" : "+v"(tid_));
    const int tid = tid_, wid = __builtin_amdgcn_readfirstlane(tid >> 6), lane = tid & 63, wr = wid >> 2, wc = wid & 3, fr = lane & 15, fq = lane >> 4;
    const int K = g.K, nt = K / BK;
    unsigned voffA[2], voffB[2];
#pragma unroll
    for (int i = 0; i < 2; ++i) { int R, C; stage_rc(tid * 16 + i * 8192, R, C); const int Rb = Epi::PERM ? ((R & ~31) + perm32(R & 31)) : R;
        voffA[i] = (unsigned)(R * g.lda + C) * 2u; voffB[i] = (unsigned)(Rb * g.ldb + C) * 2u; }
    const size_t kstep = (size_t)(BK * 2);
    const size_t hstepA = (size_t)HALF * g.lda * 2, hstepB = (size_t)HALF * g.ldb * 2;
    const size_t tstepA = 2 * hstepA, tstepB = 2 * hstepB, akb = (size_t)g.akoff * 2;
    const unsigned ldsw = (unsigned)wid * 1024u;
    const int aoff = lds_byte(wr * 64 + fr, fq * 8), boff = lds_byte(wc * 32 + fr, fq * 8);
#define PG8_SA(b, h) (((b) * 2 + (h)) * HTB)
#define PG8_SB(b, h) ((4 + (b) * 2 + (h)) * HTB)
#define PG8_STAGE(bufoff, gbase, voff) do { _Pragma("unroll") for (int _i = 0; _i < 2; ++_i) \
        __builtin_amdgcn_global_load_lds((const unsigned*)((const char*)(gbase) + (voff)[_i]), (PG8_LAS unsigned*)(lds + (bufoff) + ldsw + _i * 8192), 16, 0, 0); } while (0)
#define PG8_LDA(dst, b, h) do { _Pragma("unroll") for (int m = 0; m < 4; ++m) _Pragma("unroll") for (int k = 0; k < 2; ++k) dst[m][k] = *(const PG8_LAS bf16x8*)(lds + PG8_SA(b, h) + aoff + m * 2048 + k * 1024); } while (0)
#define PG8_LDB(dst, b, h) do { _Pragma("unroll") for (int n = 0; n < 2; ++n) _Pragma("unroll") for (int k = 0; k < 2; ++k) dst[n][k] = *(const PG8_LAS bf16x8*)(lds + PG8_SB(b, h) + boff + n * 2048 + k * 1024); } while (0)
#define PG8_MMA(ai, bj, At, Bt) do { __builtin_amdgcn_s_setprio(1); _Pragma("unroll") for (int m = 0; m < 4; ++m) _Pragma("unroll") for (int n = 0; n < 2; ++n) _Pragma("unroll") for (int k = 0; k < 2; ++k) \
        acc[ai][bj][m][n] = __builtin_amdgcn_mfma_f32_16x16x32_bf16(Bt[n][k], At[m][k], acc[ai][bj][m][n], 0, 0, 0); __builtin_amdgcn_s_setprio(0); } while (0)
#define PG8_WAIT_V(n) asm volatile("s_waitcnt vmcnt(" #n ")" ::: "memory")
#define PG8_WAIT_L(n) asm volatile("s_waitcnt lgkmcnt(" #n ")" ::: "memory")
#define PG8_BAR __builtin_amdgcn_s_barrier()
#define PG8_SCHED __builtin_amdgcn_sched_barrier(0)
    Unit cur, nxt; int ui = 0;
    if (!S.next(0, cur)) return;
    f32x4 acc[2][2][4][2];
#pragma unroll
    for (int a = 0; a < 2; ++a)
#pragma unroll
        for (int b = 0; b < 2; ++b)
#pragma unroll
            for (int m = 0; m < 4; ++m)
#pragma unroll
                for (int n = 0; n < 2; ++n) acc[a][b][m][n] = (f32x4){0.f, 0.f, 0.f, 0.f};
    bf16x8 At[4][2], B0[2][2], B1[2][2];
    const char* cA = (const char*)g.A + (size_t)cur.pm * tstepA + (size_t)(cur.pn >> g.aksh) * akb; const char* cB = (const char*)g.Bt + (size_t)cur.pn * tstepB;
    S.a_ready(cur);
    if constexpr (SP2) {
        PG8_STAGE(PG8_SB(0, 0), cB, voffB); PG8_STAGE(PG8_SB(0, 1), cB + hstepB, voffB); PG8_STAGE(PG8_SA(0, 0), cA, voffA); PG8_STAGE(PG8_SA(0, 1), cA + hstepA, voffA);
        if (wr == 1) PG8_BAR;
        PG8_WAIT_V(2); PG8_BAR;
        PG8_STAGE(PG8_SB(1, 0), cB + kstep, voffB); PG8_STAGE(PG8_SA(1, 0), cA + kstep, voffA); PG8_STAGE(PG8_SB(1, 1), cB + hstepB + kstep, voffB);
        PG8_WAIT_V(6); PG8_BAR;
    } else {
        PG8_STAGE(PG8_SB(0, 0), cB, voffB); PG8_STAGE(PG8_SA(0, 0), cA, voffA); PG8_STAGE(PG8_SB(0, 1), cB + hstepB, voffB); PG8_STAGE(PG8_SA(0, 1), cA + hstepA, voffA);
        if (wr == 1) PG8_BAR;
        PG8_WAIT_V(4); PG8_BAR;
        PG8_STAGE(PG8_SB(1, 0), cB + kstep, voffB); PG8_STAGE(PG8_SA(1, 0), cA + kstep, voffA); PG8_STAGE(PG8_SB(1, 1), cB + hstepB + kstep, voffB);
        PG8_WAIT_V(6); PG8_BAR;
    }
    for (;;) {
        const bool has_next = S.next(ui + 1, nxt);
        const char* nA = has_next ? (const char*)g.A + (size_t)nxt.pm * tstepA + (size_t)(nxt.pn >> g.aksh) * akb : cA; const char* nB = has_next ? (const char*)g.Bt + (size_t)nxt.pn * tstepB : cB;
#pragma nounroll
        for (int t = 0; t < nt; t += 2) {
            const bool last = (t == nt - 2);
            const char* a1 = cA + (size_t)(t + 1) * kstep;
            const char* a2 = last ? nA : cA + (size_t)(t + 2) * kstep; const char* b2 = last ? nB : cB + (size_t)(t + 2) * kstep;
            const char* a3 = a2 + kstep; const char* b3 = b2 + kstep;
            if (last && has_next) S.a_ready(nxt);
            if constexpr (SP2) {
            PG8_LDB(B0, 0, 0); PG8_LDB(B1, 0, 1); PG8_SCHED; PG8_LDA(At, 0, 0); PG8_STAGE(PG8_SA(1, 1), a1 + hstepA, voffA);
            PG8_WAIT_V(8); PG8_WAIT_L(0); PG8_BAR; PG8_MMA(0, 0, At, B0); PG8_MMA(0, 1, At, B1); PG8_BAR; PG8_SCHED;
            PG8_LDA(At, 0, 1); PG8_STAGE(PG8_SB(0, 0), b2, voffB); PG8_STAGE(PG8_SB(0, 1), b2 + hstepB, voffB); PG8_STAGE(PG8_SA(0, 0), a2, voffA);
            PG8_WAIT_V(8); PG8_WAIT_L(0); PG8_BAR; PG8_MMA(1, 0, At, B0); PG8_MMA(1, 1, At, B1); PG8_BAR; PG8_SCHED;
            PG8_LDB(B0, 1, 0); PG8_LDB(B1, 1, 1); PG8_SCHED; PG8_LDA(At, 1, 0); PG8_STAGE(PG8_SA(0, 1), a2 + hstepA, voffA);
            PG8_WAIT_V(8); PG8_WAIT_L(0); PG8_BAR; PG8_MMA(0, 0, At, B0); PG8_MMA(0, 1, At, B1); PG8_BAR; PG8_SCHED;
            PG8_LDA(At, 1, 1); PG8_STAGE(PG8_SB(1, 0), b3, voffB); PG8_STAGE(PG8_SB(1, 1), b3 + hstepB, voffB); PG8_STAGE(PG8_SA(1, 0), a3, voffA);
            PG8_WAIT_V(8); PG8_WAIT_L(0); PG8_BAR; PG8_MMA(1, 0, At, B0); PG8_MMA(1, 1, At, B1); PG8_BAR; PG8_SCHED;
            } else {
            PG8_LDB(B0, 0, 0); PG8_SCHED; PG8_LDA(At, 0, 0); PG8_STAGE(PG8_SA(1, 1), a1 + hstepA, voffA);
            PG8_WAIT_L(8); PG8_BAR; PG8_WAIT_L(0); PG8_MMA(0, 0, At, B0); PG8_BAR; PG8_SCHED;
            PG8_LDB(B1, 0, 1); PG8_STAGE(PG8_SB(0, 0), b2, voffB);
            PG8_BAR; PG8_WAIT_L(0); PG8_MMA(0, 1, At, B1); PG8_BAR;
            PG8_LDA(At, 0, 1); PG8_STAGE(PG8_SA(0, 0), a2, voffA);
            PG8_BAR; PG8_WAIT_L(0); PG8_MMA(1, 0, At, B0); PG8_BAR; PG8_SCHED;
            PG8_STAGE(PG8_SB(0, 1), b2 + hstepB, voffB);
            PG8_WAIT_V(6); PG8_BAR; PG8_MMA(1, 1, At, B1); PG8_BAR;
            PG8_LDB(B0, 1, 0); PG8_SCHED; PG8_LDA(At, 1, 0); PG8_STAGE(PG8_SA(0, 1), a2 + hstepA, voffA);
            PG8_WAIT_L(8); PG8_BAR; PG8_WAIT_L(0); PG8_MMA(0, 0, At, B0); PG8_BAR; PG8_SCHED;
            PG8_LDB(B1, 1, 1); PG8_STAGE(PG8_SB(1, 0), b3, voffB);
            PG8_BAR; PG8_WAIT_L(0); PG8_MMA(0, 1, At, B1); PG8_BAR;
            PG8_LDA(At, 1, 1); PG8_STAGE(PG8_SA(1, 0), a3, voffA);
            PG8_BAR; PG8_WAIT_L(0); PG8_MMA(1, 0, At, B0); PG8_BAR; PG8_SCHED;
            PG8_STAGE(PG8_SB(1, 1), b3 + hstepB, voffB);
            PG8_WAIT_V(6); PG8_BAR; PG8_MMA(1, 1, At, B1); PG8_BAR;
            }
        }
        if constexpr (ALIGN_EPI) { if (wr == 0) PG8_BAR; }
        if constexpr (!Epi::AFTER_DRAIN) { E(acc, cur, wr, wc, fr, fq); S.done(cur); }
        if (!has_next) break;
        bool keep = false; if constexpr (Epi::KEEPACC) keep = E.keep_acc(cur);
        if (!keep) {
#pragma unroll
        for (int a = 0; a < 2; ++a)
#pragma unroll
            for (int b = 0; b < 2; ++b)
#pragma unroll
                for (int m = 0; m < 4; ++m)
#pragma unroll
                    for (int n = 0; n < 2; ++n) acc[a][b][m][n] = (f32x4){0.f, 0.f, 0.f, 0.f};
        }
        cur = nxt; cA = nA; cB = nB; ++ui;
        if constexpr (ALIGN_EPI) { if (wr == 1) PG8_BAR; }
    }
    PG8_WAIT_V(0);
    if constexpr (!ALIGN_EPI) { if (wr == 0) PG8_BAR; }
    PG8_BAR;
    if constexpr (Epi::AFTER_DRAIN) { E.fused(acc, cur, wr, wc, fr, fq, lds, wid, lane); S.done(cur); }
#undef PG8_SA
#undef PG8_SB
#undef PG8_STAGE
#undef PG8_LDA
#undef PG8_LDB
#undef PG8_MMA
#undef PG8_WAIT_V
#undef PG8_WAIT_L
#undef PG8_BAR
#undef PG8_SCHED
}
}

#define LAS __attribute__((address_space(3)))
#define GAS __attribute__((address_space(1)))
typedef unsigned short bf16;
typedef unsigned v4u __attribute__((ext_vector_type(4)));
typedef unsigned v2u __attribute__((ext_vector_type(2)));
typedef float f32x4 __attribute__((ext_vector_type(4)));
typedef float f32x2 __attribute__((ext_vector_type(2)));
typedef _Float16 f16x2 __attribute__((ext_vector_type(2)));
constexpr int DM = 2048, NB = 2, SEQ = 8192, DEPTH = 4, T = NB * SEQ, INC = 10240, NWAVES = 8;
constexpr int C_Q = 0, C_F = 1024, C_VA = 2048, C_ZA = 3072, C_VB = 4096, C_ZB = 5120, C_GA = 6144, C_GB = 8192;
constexpr float EPS = 1e-6f;
constexpr int LDH = DM + 64;
constexpr int LDS_BYTES = 163840;
constexpr size_t MiB = 1u << 20;
constexpr size_t WS_WIN = 0;
constexpr size_t WS_WPA = WS_WIN + 176 * MiB;
constexpr size_t WS_WPB = WS_WPA + 16 * MiB;
constexpr size_t WS_WOUT = WS_WPB + 16 * MiB;
constexpr size_t WS_WPOOL = WS_WOUT + 32 * MiB;
constexpr size_t WS_MODP = WS_WPOOL + 2 * MiB;
constexpr size_t WS_MOD = WS_MODP + 3 * MiB;
constexpr size_t WS_LB = WS_MOD + 512 * 1024;
constexpr size_t WS_BAR = WS_MOD + 768 * 1024;
constexpr size_t WS_DT = WS_BAR + 64 * 1024;
constexpr size_t WS_H = WS_MOD + 1 * MiB;
constexpr size_t WS_PROJ = WS_H + 72 * MiB;
constexpr size_t WS_LF = WS_PROJ + 320 * MiB;
constexpr size_t WS_POOLED = WS_LF + 64 * MiB;
constexpr size_t WS_Y = WS_POOLED + 32 * MiB;
constexpr size_t WS_T1 = WS_Y + 64 * MiB;
constexpr size_t WS_WVB = WS_T1;
constexpr size_t WS_MERGED = WS_T1 + 128 * MiB;
constexpr size_t WS_OUT = WS_MERGED + 64 * MiB;
constexpr size_t WS_G = WS_OUT + 64 * MiB;
constexpr size_t WS_S = WS_G + 16 * MiB;
constexpr size_t WS_GT = WS_S + 16 * MiB;
constexpr size_t WS_END = WS_GT + 128 * MiB;

__device__ __forceinline__ float bf2f(unsigned b) { return __uint_as_float(b << 16); }
__device__ __forceinline__ unsigned pk2(float lo, float hi) { return pg8::cvt_pk_bf16(lo, hi); }
__device__ __forceinline__ unsigned pkh2(float lo, float hi) { const f16x2 v = {(_Float16)lo, (_Float16)hi}; return __builtin_bit_cast(unsigned, v); }
__device__ __forceinline__ float sigm(float x) { return __builtin_amdgcn_rcpf(1.0f + __expf(-x)); }
__device__ __forceinline__ float xshfl(float v, int o, int lane) { return __int_as_float(__builtin_amdgcn_ds_bpermute((lane ^ o) << 2, __float_as_int(v))); }
__device__ __forceinline__ float wave_sum(float v, int lane) {
#pragma unroll
    for (int o = 1; o < 64; o <<= 1) v += xshfl(v, o, lane);
    return v;
}
#define LDS_WAIT() asm volatile("s_waitcnt lgkmcnt(0)" ::: "memory")

typedef pg8::f32x4 af4;
struct EpiProj {
    static constexpr bool PERM = true, AFTER_DRAIN = false, KEEPACC = false;
    bf16* P; unsigned short* LF; const float* lb; v4u* GT;
    __device__ __forceinline__ void operator()(const af4 (&acc)[2][2][4][2], const pg8::Unit& u, int wr, int wc, int fr, int fq) const {
        const int row0 = u.pm * 256 + wr * 64 + fr, colb = u.pn * 256 + wc * 32 + 8 * fq;
        const int pn = u.pn;
        const int mode = (pn < 4) ? 1 : (pn < 8) ? 3 : (pn < 12) ? 0 : (pn < 16) ? 1 : (pn < 20) ? 0 : (pn < 24) ? 1 : 2;
        if (mode == 3) {
            float lbv[2][8];
#pragma unroll
            for (int bj = 0; bj < 2; ++bj) { const f32x4 a = *(const f32x4*)(lb + colb - C_F + bj * 128), b = *(const f32x4*)(lb + colb - C_F + bj * 128 + 4);
                lbv[bj][0] = a[0]; lbv[bj][1] = a[1]; lbv[bj][2] = a[2]; lbv[bj][3] = a[3]; lbv[bj][4] = b[0]; lbv[bj][5] = b[1]; lbv[bj][6] = b[2]; lbv[bj][7] = b[3]; }
#pragma unroll
            for (int ai = 0; ai < 2; ++ai)
#pragma unroll
                for (int m = 0; m < 4; ++m) { const size_t row = (size_t)(row0 + ai * 128 + m * 16);
#pragma unroll
                    for (int bj = 0; bj < 2; ++bj) { float kk[8], lf[8];
#pragma unroll
                        for (int j = 0; j < 8; ++j) { const float a = acc[ai][bj][m][j >> 2][j & 3], l = lbv[bj][j];
                            const float sg = __builtin_amdgcn_rcpf(1.0f + __expf(-a)), sn = __builtin_amdgcn_rcpf(1.0f + __expf(a));
                            const float f = l + (1.0f - l) * sg; lf[j] = __logf(fmaxf(f, 1e-30f)); kk[j] = (1.0f - l) * sn; }
                        v4u w; w.x = pk2(kk[0], kk[1]); w.y = pk2(kk[2], kk[3]); w.z = pk2(kk[4], kk[5]); w.w = pk2(kk[6], kk[7]);
                        *(v4u*)(P + row * INC + colb + bj * 128) = w;
                        *(v4u*)(LF + row * 1024 + (colb - C_F) + bj * 128) = (v4u){pkh2(lf[0], lf[1]), pkh2(lf[2], lf[3]), pkh2(lf[4], lf[5]), pkh2(lf[6], lf[7])}; } }
        } else {
#pragma unroll
            for (int ai = 0; ai < 2; ++ai)
#pragma unroll
                for (int m = 0; m < 4; ++m) { const size_t row = (size_t)(row0 + ai * 128 + m * 16);
#pragma unroll
                    for (int bj = 0; bj < 2; ++bj) { float o[8];
#pragma unroll
                        for (int j = 0; j < 8; ++j) { const float a = acc[ai][bj][m][j >> 2][j & 3];
                            o[j] = (mode == 0) ? a : (mode == 1) ? a * sigm(a) : sigm(a); }
                        v4u w; w.x = pk2(o[0], o[1]); w.y = pk2(o[2], o[3]); w.z = pk2(o[4], o[5]); w.w = pk2(o[6], o[7]);
                        if (mode == 2) GT[((size_t)(((pn - 24) >> 3) * 512 + u.pm * 8 + ((pn - 24) & 7)) * 16 + (ai * 4 + m) * 2 + bj) * 512 + (wr * 4 + wc) * 64 + fq * 16 + fr] = w;
                        else *(v4u*)(P + row * INC + colb + bj * 128) = w; } }
        }
    }
};
template <int MODE> struct EpiGen {
    static constexpr bool PERM = true, AFTER_DRAIN = false, KEEPACC = false; static constexpr int MB = (MODE == 3) ? 2 : 4;
    bf16* O; int ldo; float* F; int ldf; const bf16* X; int ldx; const float* vec;
    __device__ __forceinline__ void operator()(const af4 (&acc)[2][2][4][2], const pg8::Unit& u, int wr, int wc, int fr, int fq) const {
        const int row0 = u.pm * 256 + wr * 64 + fr, colb = u.pn * 256 + wc * 32 + 8 * fq;
        f32x4 va[2], vb[2];
        if (MODE == 1) {
#pragma unroll
            for (int bj = 0; bj < 2; ++bj) { va[bj] = *(const f32x4*)(vec + colb + bj * 128); vb[bj] = *(const f32x4*)(vec + colb + bj * 128 + 4); } }
#pragma unroll
        for (int aim = 0; aim < 2 * (4 / MB); ++aim) { const int ai = aim / (4 / MB), mb = (aim % (4 / MB)) * MB;
            v4u xw[MB][2]; f32x4 fa[MB][2], fb[MB][2];
            if (MODE != 0) {
#pragma unroll
                for (int m = 0; m < MB; ++m)
#pragma unroll
                    for (int bj = 0; bj < 2; ++bj) xw[m][bj] = *(const v4u*)(X + (size_t)(row0 + ai * 128 + (mb + m) * 16) * ldx + colb + bj * 128); }
            if (MODE == 3) {
#pragma unroll
                for (int m = 0; m < MB; ++m)
#pragma unroll
                    for (int bj = 0; bj < 2; ++bj) { const float* fp = F + (size_t)(row0 + ai * 128 + (mb + m) * 16) * ldf + colb + bj * 128; fa[m][bj] = *(const f32x4*)fp; fb[m][bj] = *(const f32x4*)(fp + 4); } }
#pragma unroll
            for (int m = 0; m < MB; ++m) { const size_t row = (size_t)(row0 + ai * 128 + (mb + m) * 16);
#pragma unroll
                for (int bj = 0; bj < 2; ++bj) { const int col = colb + bj * 128; float o[8];
#pragma unroll
                    for (int j = 0; j < 8; ++j) o[j] = acc[ai][bj][mb + m][j >> 2][j & 3];
                    if (MODE != 0) { const v4u w4 = xw[m][bj];
                        o[0] *= bf2f(w4.x & 0xffffu); o[1] *= bf2f(w4.x >> 16); o[2] *= bf2f(w4.y & 0xffffu); o[3] *= bf2f(w4.y >> 16); o[4] *= bf2f(w4.z & 0xffffu); o[5] *= bf2f(w4.z >> 16); o[6] *= bf2f(w4.w & 0xffffu); o[7] *= bf2f(w4.w >> 16); }
                    if (MODE == 1) { o[0] *= va[bj][0]; o[1] *= va[bj][1]; o[2] *= va[bj][2]; o[3] *= va[bj][3]; o[4] *= vb[bj][0]; o[5] *= vb[bj][1]; o[6] *= vb[bj][2]; o[7] *= vb[bj][3]; }
                    if (MODE == 2) { float* fp = F + row * ldf + col; *(f32x4*)fp = (f32x4){o[0], o[1], o[2], o[3]}; *(f32x4*)(fp + 4) = (f32x4){o[4], o[5], o[6], o[7]}; }
                    else { if (MODE == 3) { o[0] += fa[m][bj][0]; o[1] += fa[m][bj][1]; o[2] += fa[m][bj][2]; o[3] += fa[m][bj][3]; o[4] += fb[m][bj][0]; o[5] += fb[m][bj][1]; o[6] += fb[m][bj][2]; o[7] += fb[m][bj][3]; }
                        v4u w; w.x = pk2(o[0], o[1]); w.y = pk2(o[2], o[3]); w.z = pk2(o[4], o[5]); w.w = pk2(o[6], o[7]);
                        *(v4u*)(O + row * ldo + col) = w; } } }
        }
    }
};
struct EpiPair {
    static constexpr bool PERM = true, AFTER_DRAIN = false, KEEPACC = true;
    bf16* O; const v4u* GT;
    __device__ __forceinline__ bool keep_acc(const pg8::Unit& u) const { return u.pn < 8; }
    __device__ __forceinline__ void operator()(af4 (&acc)[2][2][4][2], const pg8::Unit& u, int wr, int wc, int fr, int fq) const {
        const int row0 = u.pm * 256 + wr * 64 + fr, colb = (u.pn & 7) * 256 + wc * 32 + 8 * fq;
        const v4u* ga4 = GT + (size_t)(u.pm * 8 + (u.pn & 7)) * 16 * 512 + (wr * 4 + wc) * 64 + fq * 16 + fr; const v4u* gb4 = ga4 + (size_t)512 * 16 * 512;
        if (u.pn < 8) {
#pragma unroll
            for (int aim = 0; aim < 2; ++aim) { const int ai = aim, mb = 0;
                v4u xa[4][2], xb[4][2];
#pragma unroll
                for (int m = 0; m < 4; ++m)
#pragma unroll
                    for (int bj = 0; bj < 2; ++bj) { const int o = ((ai * 4 + mb + m) * 2 + bj) * 512; xb[m][bj] = gb4[o]; xa[m][bj] = ga4[o]; }
#pragma unroll
                for (int m = 0; m < 4; ++m)
#pragma unroll
                    for (int bj = 0; bj < 2; ++bj) { const unsigned wa[4] = {xa[m][bj].x, xa[m][bj].y, xa[m][bj].z, xa[m][bj].w}, wb[4] = {xb[m][bj].x, xb[m][bj].y, xb[m][bj].z, xb[m][bj].w};
#pragma unroll
                        for (int j = 0; j < 4; ++j) { const float r0 = bf2f(wa[j] & 0xffffu) * __builtin_amdgcn_rcpf(fmaxf(bf2f(wb[j] & 0xffffu), 1e-30f)), r1 = bf2f(wa[j] >> 16) * __builtin_amdgcn_rcpf(fmaxf(bf2f(wb[j] >> 16), 1e-30f));
                            acc[ai][bj][mb + m][j >> 1][(2 * j) & 3] *= r0; acc[ai][bj][mb + m][j >> 1][(2 * j + 1) & 3] *= r1; } }
            }
        } else {
#pragma unroll
            for (int ai = 0; ai < 2; ++ai) {
                v4u xb[4][2];
#pragma unroll
                for (int m = 0; m < 4; ++m)
#pragma unroll
                    for (int bj = 0; bj < 2; ++bj) xb[m][bj] = gb4[((ai * 4 + m) * 2 + bj) * 512];
#pragma unroll
                for (int m = 0; m < 4; ++m)
#pragma unroll
                    for (int bj = 0; bj < 2; ++bj) { const unsigned wb[4] = {xb[m][bj].x, xb[m][bj].y, xb[m][bj].z, xb[m][bj].w}; unsigned w[4];
#pragma unroll
                        for (int j = 0; j < 4; ++j) w[j] = pk2(acc[ai][bj][m][j >> 1][(2 * j) & 3] * fmaxf(bf2f(wb[j] & 0xffffu), 1e-30f), acc[ai][bj][m][j >> 1][(2 * j + 1) & 3] * fmaxf(bf2f(wb[j] >> 16), 1e-30f));
                        *(v4u*)(O + (size_t)(row0 + ai * 128 + m * 16) * DM + colb + bj * 128) = (v4u){w[0], w[1], w[2], w[3]}; }
            }
        }
    }
};
struct PairOrder : pg8::StaticOrder {
    __device__ __forceinline__ bool next(int i, pg8::Unit& u) const { if (!pg8::StaticOrder::next(i >> 1, u)) return false; u.pn += 8 * (i & 1); return true; }
};
struct EpiFold {
    static constexpr bool PERM = true, AFTER_DRAIN = false, KEEPACC = false;
    bf16* WINp; const float* ps;
    __device__ __forceinline__ void operator()(const af4 (&acc)[2][2][4][2], const pg8::Unit& u, int wr, int wc, int fr, int fq) const {
        const int row0 = u.pm * 256 + wr * 64 + fr, colb = u.pn * 256 + wc * 32 + 8 * fq;
        float g[2][8];
#pragma unroll
        for (int bj = 0; bj < 2; ++bj)
#pragma unroll
            for (int j = 0; j < 8; ++j) g[bj][j] = ps[colb + bj * 128 + j];
#pragma unroll
        for (int ai = 0; ai < 2; ++ai)
#pragma unroll
            for (int m = 0; m < 4; ++m) { const int k = row0 + ai * 128 + m * 16;
#pragma unroll
                for (int bj = 0; bj < 2; ++bj)
#pragma unroll
                    for (int j = 0; j < 8; ++j) { const int n = colb + bj * 128 + j;
                        WINp[((size_t)(n >> 10) * INC + C_VB + (n & 1023)) * LDH + k] = (bf16)(pk2(acc[ai][bj][m][j >> 2][j & 3] * g[bj][j], 0.f) & 0xffffu); } }
    }
};
struct Params {
    const float *x, *c, *w_ada, *b_ada, *norm_pre, *norm_post, *w_in, *lower_bounds, *hgrn_norm, *pool_w, *pool_scale, *w_proj_a, *w_proj_b, *w_out;
    float* out; unsigned char* ws;
};

struct TItem { const float* src; bf16* dst; const float* rs; int N, ldt; };
__device__ __forceinline__ TItem titem_mk(const float* W, int K, int N, bf16* WT, int ldt, int item, const float* rs = nullptr) {
    const int nblk = N / 64, kb = item / nblk, nb = item % nblk;
    TItem t; t.src = W + (size_t)(64 * kb) * N + 64 * nb; t.dst = WT + (size_t)(64 * nb) * ldt + 64 * kb; t.rs = rs ? rs + 64 * kb : nullptr; t.N = N; t.ldt = ldt; return t;
}
__device__ __forceinline__ void titem_load(const TItem& t, f32x4 (&r)[16], int lane) {
#pragma unroll
    for (int i = 0; i < 16; ++i) r[i] = *(const f32x4*)(t.src + (size_t)(4 * i + (lane >> 4)) * t.N + 4 * (lane & 15));
}
__device__ __forceinline__ void phase0(const Params& p, LAS unsigned char* lds, int tid, int wave, int lane, int G, int bidx) {
    LAS float* cact = (LAS float*)lds;
    LAS float* scr = (LAS float*)(lds + 16384 + wave * 16640);
    for (int i = tid; i < NB * DM; i += NWAVES * 64) { const float v = p.c[i]; cact[i] = v * sigm(v); }
    __syncthreads();
    const int gw = bidx * NWAVES + wave, NGW = G * NWAVES;
    float* modp = (float*)(p.ws + WS_MODP);
    for (int it = gw; it < DEPTH * 24 * 16; it += NGW) {
        const int ks = it & 15, cgp = (it >> 4) % 24, l = it / (16 * 24);
        const int col0 = cgp * 256 + lane * 4, k0 = ks * 128;
        const float* w = p.w_ada + ((size_t)l * DM + k0) * 6144 + col0;
        f32x4 a0 = {0.f, 0.f, 0.f, 0.f}, a1 = {0.f, 0.f, 0.f, 0.f};
#pragma unroll 16
        for (int k = 0; k < 128; ++k) { const f32x4 wv = *(const f32x4*)(w + (size_t)k * 6144); const float c0 = cact[k0 + k], c1 = cact[DM + k0 + k]; a0 += wv * c0; a1 += wv * c1; }
        *(f32x4*)(modp + ((size_t)(ks * DEPTH + l) * 2 + 0) * 6144 + col0) = a0;
        *(f32x4*)(modp + ((size_t)(ks * DEPTH + l) * 2 + 1) * 6144 + col0) = a1;
    }
    constexpr int I_IN = 32 * 160, I_PA = 16 * 32, I_OUT = 32 * 32, I_POOL = 4 * 16, I_L = I_IN + 2 * I_PA + I_OUT + I_POOL;
    bf16* WIN = (bf16*)(p.ws + WS_WIN); bf16* WPA = (bf16*)(p.ws + WS_WPA); bf16* WPB = (bf16*)(p.ws + WS_WPB); bf16* WOUT = (bf16*)(p.ws + WS_WOUT); bf16* WPOOL = (bf16*)(p.ws + WS_WPOOL);
    auto mk = [&](int it) -> TItem {
        const int l = it / I_L; int r = it % I_L;
        if (r < I_IN) return titem_mk(p.w_in + (size_t)l * DM * INC, DM, INC, WIN + (size_t)l * INC * LDH, LDH, r); r -= I_IN;
        if (r < I_PA) return titem_mk(p.w_proj_a + (size_t)l * 1024 * DM, 1024, DM, WPA + (size_t)l * 4096 * 1024, 1024, r, p.hgrn_norm + l * 1024); r -= I_PA;
        if (r < I_PA) return titem_mk(p.w_proj_b + (size_t)l * 1024 * DM, 1024, DM, WPA + ((size_t)l * 4096 + 2048) * 1024, 1024, r); r -= I_PA;
        if (r < I_OUT) return titem_mk(p.w_out + (size_t)l * DM * DM, DM, DM, WOUT + (size_t)l * DM * DM, DM, r); r -= I_OUT;
        const int g = r / 16; return titem_mk(p.pool_w + (size_t)(l * 4 + g) * 65536, 256, 256, WPOOL + (size_t)(l * 1024 + g * 256) * 256, 256, r % 16);
    };
    if (gw < DEPTH * I_L) {
        f32x4 rg[16]; TItem cur = mk(gw); titem_load(cur, rg, lane);
        for (int it = gw; it < DEPTH * I_L; it += NGW) {
#pragma unroll
            for (int i = 0; i < 16; ++i) { LAS float* w = scr + (4 * i + (lane >> 4)) * 65 + 4 * (lane & 15); const float g = cur.rs ? cur.rs[4 * i + (lane >> 4)] : 1.0f; w[0] = rg[i][0] * g; w[1] = rg[i][1] * g; w[2] = rg[i][2] * g; w[3] = rg[i][3] * g; }
            TItem nxt = cur;
            if (it + NGW < DEPTH * I_L) { nxt = mk(it + NGW); titem_load(nxt, rg, lane); }
            LDS_WAIT(); asm volatile("" ::: "memory");
            const int c = lane & 7;
#pragma unroll
            for (int j = 0; j < 8; ++j) { const int n = (lane >> 3) + 8 * j; const LAS float* sp = scr + (8 * c) * 65 + n;
                v4u o; o.x = pk2(sp[0 * 65], sp[1 * 65]); o.y = pk2(sp[2 * 65], sp[3 * 65]); o.z = pk2(sp[4 * 65], sp[5 * 65]); o.w = pk2(sp[6 * 65], sp[7 * 65]);
                *(v4u*)(cur.dst + (size_t)n * cur.ldt + 8 * c) = o; }
            LDS_WAIT(); asm volatile("" ::: "memory");
            cur = nxt;
        }
    }
    {
        bf16* WVB = (bf16*)(p.ws + WS_WVB);
        for (int i = bidx * (NWAVES * 64) + tid; i < DEPTH * DM * 128; i += G * NWAVES * 64) { const int c8 = i & 127, k = (i >> 7) & (DM - 1), l = i >> 18;
            const float* src = p.w_in + ((size_t)l * DM + k) * INC + C_VB + c8 * 8; const f32x4 a = *(const f32x4*)src, b = *(const f32x4*)(src + 4);
            *(v4u*)(WVB + (size_t)k * 4096 + l * 1024 + c8 * 8) = (v4u){pk2(a[0], a[1]), pk2(a[2], a[3]), pk2(b[0], b[1]), pk2(b[2], b[3])}; }
    }
    if (bidx == 0) {
        float* lbo = (float*)(p.ws + WS_LB);
        for (int i = tid; i < 1024; i += NWAVES * 64) {
            const float v0 = p.lower_bounds[i], v1 = p.lower_bounds[1024 + i], v2 = p.lower_bounds[2048 + i], v3 = p.lower_bounds[3072 + i];
            const float mx = fmaxf(fmaxf(v0, v1), fmaxf(v2, v3));
            const float e0 = expf(v0 - mx), e1 = expf(v1 - mx), e2 = expf(v2 - mx), e3 = expf(v3 - mx), inv = 1.0f / (e0 + e1 + e2 + e3);
            lbo[i] = 0.f; lbo[1024 + i] = e1 * inv; lbo[2048 + i] = (e1 + e2) * inv; lbo[3072 + i] = (e1 + e2 + e3) * inv;
        }
    }
}
__device__ __forceinline__ void phase_mod(const Params& p, int tid, int G, int bidx) {
    const float* modp = (const float*)(p.ws + WS_MODP); float* mod = (float*)(p.ws + WS_MOD);
    for (int i = bidx * (NWAVES * 64) + tid; i < DEPTH * 2 * 6144; i += G * NWAVES * 64) {
        const int l = i / (2 * 6144), cidx = i % 6144;
        float s = p.b_ada[l * 6144 + cidx];
#pragma unroll
        for (int ks = 0; ks < 16; ++ks) s += modp[(size_t)ks * (DEPTH * 2 * 6144) + i];
        mod[i] = s;
    }
}
template <bool HAS_OUT, bool XB16> __device__ __forceinline__ void rp_load(f32x4 (&xf)[8], v2u (&xh)[8], v2u (&ow)[8], const float* xsrc, const bf16* XB, const bf16* OUT, int r, int lane) {
#pragma unroll
    for (int j = 0; j < 8; ++j) { if (XB16) xh[j] = *(const v2u*)(XB + (size_t)r * DM + j * 256 + lane * 4); else xf[j] = *(const f32x4*)(xsrc + (size_t)r * DM + j * 256 + lane * 4);
        if (HAS_OUT) ow[j] = *(const v2u*)(OUT + (size_t)r * DM + j * 256 + lane * 4); }
}
template <int RM> __device__ __forceinline__ void rp_row(const f32x4 (&xf)[8], const v2u (&xh)[8], const v2u (&ow)[8], float* xout, bf16* XB, bf16* H, LAS unsigned char* lds, int r, int lane) {
    constexpr bool HAS_OUT = RM >= 1, HAS_H = RM <= 2, XB16 = RM >= 2;
    const LAS float* vec = (const LAS float*)lds + (r >> 13) * 3 * DM;
    f32x4 x[8];
#pragma unroll
    for (int j = 0; j < 8; ++j) x[j] = XB16 ? (f32x4){bf2f(xh[j].x & 0xffffu), bf2f(xh[j].x >> 16), bf2f(xh[j].y & 0xffffu), bf2f(xh[j].y >> 16)} : xf[j];
    if (HAS_OUT) {
        f32x4 o[8]; float ss = 0.f;
#pragma unroll
        for (int j = 0; j < 8; ++j) { o[j] = (f32x4){bf2f(ow[j].x & 0xffffu), bf2f(ow[j].x >> 16), bf2f(ow[j].y & 0xffffu), bf2f(ow[j].y >> 16)};
            ss += (o[j][0] * o[j][0] + o[j][1] * o[j][1]) + (o[j][2] * o[j][2] + o[j][3] * o[j][3]); }
        const float rinv = rsqrtf(wave_sum(ss, lane) * (1.0f / DM) + EPS);
#pragma unroll
        for (int j = 0; j < 8; ++j) { x[j] = x[j] + *(const LAS f32x4*)(vec + j * 256 + lane * 4) * (o[j] * rinv);
            if (RM == 3) *(f32x4*)(xout + (size_t)r * DM + j * 256 + lane * 4) = x[j];
            else *(v2u*)(XB + (size_t)r * DM + j * 256 + lane * 4) = (v2u){pk2(x[j][0], x[j][1]), pk2(x[j][2], x[j][3])}; }
    }
    if (HAS_H) {
        float ss = 0.f;
#pragma unroll
        for (int j = 0; j < 8; ++j) ss += (x[j][0] * x[j][0] + x[j][1] * x[j][1]) + (x[j][2] * x[j][2] + x[j][3] * x[j][3]);
        const float rinv = rsqrtf(wave_sum(ss, lane) * (1.0f / DM) + EPS);
#pragma unroll
        for (int j = 0; j < 8; ++j) { const f32x4 h = (x[j] * rinv) * *(const LAS f32x4*)(vec + DM + j * 256 + lane * 4) + *(const LAS f32x4*)(vec + 2 * DM + j * 256 + lane * 4);
            v2u w; w.x = pk2(h[0], h[1]); w.y = pk2(h[2], h[3]);
            *(v2u*)(H + (size_t)r * LDH + j * 256 + lane * 4) = w; }
    }
}
template <int RM  >
__device__ __forceinline__ void row_pass(const Params& p, LAS unsigned char* lds, int l, int tid, int wave, int lane, int G, int bidx) {
    constexpr bool HAS_OUT = RM >= 1, HAS_H = RM <= 2, XB16 = RM >= 2;
    const float* mod = (const float*)(p.ws + WS_MOD); const bf16* OUT = (const bf16*)(p.ws + WS_OUT); bf16* H = (bf16*)(p.ws + WS_H); bf16* XB = (bf16*)(p.ws + WS_T1 + 32 * MiB);
    const int gw = bidx * NWAVES + wave, NGW = G * NWAVES;
    {
        LAS float* vec = (LAS float*)lds;
        for (int i = tid; i < NB * DM; i += NWAVES * 64) { const int b = i >> 11, c = i & (DM - 1);
            if (HAS_OUT) vec[(b * 3 + 0) * DM + c] = mod[(size_t)((l - 1) * 2 + b) * 6144 + 4096 + c] * p.norm_post[(l - 1) * DM + c];
            if (HAS_H) { vec[(b * 3 + 1) * DM + c] = p.norm_pre[l * DM + c] * (1.0f + mod[(size_t)(l * 2 + b) * 6144 + 2048 + c]); vec[(b * 3 + 2) * DM + c] = mod[(size_t)(l * 2 + b) * 6144 + c]; } }
        __syncthreads();
    }
    const int n = (gw < T) ? (T - gw + NGW - 1) / NGW : 0;
    f32x4 fa[8], fb[8], fc[8]; v2u ha[8], hb[8], hc[8], oa[8], ob[8], oc[8];
    if (n > 0) rp_load<HAS_OUT, XB16>(fa, ha, oa, p.x, XB, OUT, gw, lane);
    if (n > 1) rp_load<HAS_OUT, XB16>(fb, hb, ob, p.x, XB, OUT, gw + NGW, lane);
    for (int i = 0; i < n; i += 3) {
        if (i + 2 < n) rp_load<HAS_OUT, XB16>(fc, hc, oc, p.x, XB, OUT, gw + (i + 2) * NGW, lane);
        rp_row<RM>(fa, ha, oa, p.out, XB, H, lds, gw + i * NGW, lane);
        if (i + 1 < n) { if (i + 3 < n) rp_load<HAS_OUT, XB16>(fa, ha, oa, p.x, XB, OUT, gw + (i + 3) * NGW, lane);
            rp_row<RM>(fb, hb, ob, p.out, XB, H, lds, gw + (i + 1) * NGW, lane); }
        if (i + 2 < n) { if (i + 4 < n) rp_load<HAS_OUT, XB16>(fb, hb, ob, p.x, XB, OUT, gw + (i + 4) * NGW, lane);
            rp_row<RM>(fc, hc, oc, p.out, XB, H, lds, gw + (i + 2) * NGW, lane); }
    }
    __syncthreads();
}
template <int WMAX> __device__ __forceinline__ void pooled_half(const bf16* P, bf16* PO, int r, int t, int c) {
    const int w = 2 << (c >> 8), n = (t + 1 < w) ? t + 1 : w;
    v4u q[WMAX];
#pragma unroll
    for (int i = 0; i < WMAX; ++i) { const int back = (i < n) ? i : 0; q[i] = *(const v4u*)(P + (size_t)(r - back) * INC + C_VB + c); }
    float s[8], v0[8];
#pragma unroll
    for (int j = 0; j < 8; ++j) s[j] = 0.f;
#pragma unroll
    for (int i = 0; i < WMAX; ++i) { const float e[8] = {bf2f(q[i].x & 0xffffu), bf2f(q[i].x >> 16), bf2f(q[i].y & 0xffffu), bf2f(q[i].y >> 16), bf2f(q[i].z & 0xffffu), bf2f(q[i].z >> 16), bf2f(q[i].w & 0xffffu), bf2f(q[i].w >> 16)};
        const float keep = (i < n) ? 1.0f : 0.0f;
#pragma unroll
        for (int j = 0; j < 8; ++j) { s[j] += keep * e[j]; if (i == 0) v0[j] = e[j]; } }
    const float inv = 1.0f / (float)n;
    v4u o; o.x = pk2(s[0] * inv - v0[0], s[1] * inv - v0[1]); o.y = pk2(s[2] * inv - v0[2], s[3] * inv - v0[3]); o.z = pk2(s[4] * inv - v0[4], s[5] * inv - v0[5]); o.w = pk2(s[6] * inv - v0[6], s[7] * inv - v0[7]);
    *(v4u*)(PO + (size_t)r * 1024 + c) = o;
}
__device__ __forceinline__ void pooled_pass(const Params& p, int wave, int lane, int G, int bidx) {
    const bf16* P = (const bf16*)(p.ws + WS_PROJ); bf16* PO = (bf16*)(p.ws + WS_POOLED);
    const int gw = bidx * NWAVES + wave, NGW = G * NWAVES;
    for (int r = gw; r < T; r += NGW) { const int t = r & (SEQ - 1);
        pooled_half<4>(P, PO, r, t, lane * 8);
        pooled_half<16>(P, PO, r, t, 512 + lane * 8); }
}
template <int WMAX> __device__ __forceinline__ void yb_half(const bf16* P, bf16* Y, const float* ps, int r, int t, int c) {
    const int w = 2 << (c >> 8), n = (t + 1 < w) ? t + 1 : w;
    v4u q[WMAX];
#pragma unroll
    for (int i = 0; i < WMAX; ++i) { const int back = (i < n) ? i : 0; q[i] = *(const v4u*)(P + (size_t)(r - back) * INC + C_VB + c); }
    const v4u zq = *(const v4u*)(P + (size_t)r * INC + C_ZB + c);
    float s[8], v0[8];
#pragma unroll
    for (int j = 0; j < 8; ++j) s[j] = 0.f;
#pragma unroll
    for (int i = 0; i < WMAX; ++i) { const float e[8] = {bf2f(q[i].x & 0xffffu), bf2f(q[i].x >> 16), bf2f(q[i].y & 0xffffu), bf2f(q[i].y >> 16), bf2f(q[i].z & 0xffffu), bf2f(q[i].z >> 16), bf2f(q[i].w & 0xffffu), bf2f(q[i].w >> 16)};
        const float keep = (i < n) ? 1.0f : 0.0f;
#pragma unroll
        for (int j = 0; j < 8; ++j) { s[j] += keep * e[j]; if (i == 0) v0[j] = e[j]; } }
    const float inv = 1.0f / (float)n;
    const float z[8] = {bf2f(zq.x & 0xffffu), bf2f(zq.x >> 16), bf2f(zq.y & 0xffffu), bf2f(zq.y >> 16), bf2f(zq.z & 0xffffu), bf2f(zq.z >> 16), bf2f(zq.w & 0xffffu), bf2f(zq.w >> 16)};
    float y[8];
#pragma unroll
    for (int j = 0; j < 8; ++j) y[j] = (s[j] * inv - v0[j]) * z[j];
    *(v4u*)(Y + (size_t)r * DM + 1024 + c) = (v4u){pk2(y[0], y[1]), pk2(y[2], y[3]), pk2(y[4], y[5]), pk2(y[6], y[7])};
}
template <int WMAX, int NO> __device__ __forceinline__ void yb_block(const bf16* P, bf16* Y, int R0, int c) {
    constexpr int NR = WMAX - 1 + NO;
    const int w = 2 << (c >> 8), t0 = R0 & (SEQ - 1), seq0 = R0 - t0;
    const float big = (w == WMAX) ? 1.0f : 0.0f;
    v4u q[NR], zq[NO];
#pragma unroll
    for (int k = 0; k < NR; ++k) { const int row = R0 - (WMAX - 1) + k; const bool ok = row >= seq0;
        const v4u v = *(const v4u*)(P + (size_t)(ok ? row : seq0) * INC + C_VB + c);
        q[k] = ok ? v : (v4u){0u, 0u, 0u, 0u}; }
#pragma unroll
    for (int i = 0; i < NO; ++i) zq[i] = *(const v4u*)(P + (size_t)(R0 + i) * INC + C_ZB + c);
    float s[NO][8];
#pragma unroll
    for (int i = 0; i < NO; ++i)
#pragma unroll
        for (int j = 0; j < 8; ++j) s[i][j] = 0.f;
#pragma unroll
    for (int k = 0; k < NR; ++k) { const v4u r = q[k];
        const float e[8] = {bf2f(r.x & 0xffffu), bf2f(r.x >> 16), bf2f(r.y & 0xffffu), bf2f(r.y >> 16), bf2f(r.z & 0xffffu), bf2f(r.z >> 16), bf2f(r.w & 0xffffu), bf2f(r.w >> 16)};
        float eb[8];
#pragma unroll
        for (int j = 0; j < 8; ++j) eb[j] = e[j] * big;
#pragma unroll
        for (int i = 0; i < NO; ++i) { const int jj = WMAX - 1 + i - k;
            if (jj >= 0 && jj < WMAX) {
#pragma unroll
                for (int j = 0; j < 8; ++j) s[i][j] += (jj < WMAX / 2) ? e[j] : eb[j]; } } }
#pragma unroll
    for (int i = 0; i < NO; ++i) { const int t = t0 + i, n = (t + 1 < w) ? t + 1 : w; const float inv = 1.0f / (float)n; const v4u r = q[WMAX - 1 + i], z4 = zq[i];
        const float v0[8] = {bf2f(r.x & 0xffffu), bf2f(r.x >> 16), bf2f(r.y & 0xffffu), bf2f(r.y >> 16), bf2f(r.z & 0xffffu), bf2f(r.z >> 16), bf2f(r.w & 0xffffu), bf2f(r.w >> 16)};
        const float z[8] = {bf2f(z4.x & 0xffffu), bf2f(z4.x >> 16), bf2f(z4.y & 0xffffu), bf2f(z4.y >> 16), bf2f(z4.z & 0xffffu), bf2f(z4.z >> 16), bf2f(z4.w & 0xffffu), bf2f(z4.w >> 16)};
        float y[8];
#pragma unroll
        for (int j = 0; j < 8; ++j) y[j] = (s[i][j] * inv - v0[j]) * z[j];
        *(v4u*)(Y + (size_t)(R0 + i) * DM + 1024 + c) = (v4u){pk2(y[0], y[1]), pk2(y[2], y[3]), pk2(y[4], y[5]), pk2(y[6], y[7])}; }
}
__device__ __forceinline__ void yb_pass(const Params& p, int l, int wave, int lane, int G, int bidx) {
    const bf16* P = (const bf16*)(p.ws + WS_PROJ); bf16* Y = (bf16*)(p.ws + WS_Y);
    const int gw = bidx * NWAVES + wave, NGW = G * NWAVES;
    for (int R0 = gw * 4; R0 < T; R0 += NGW * 4) {
        yb_block<4, 4>(P, Y, R0, lane * 8);
        yb_block<16, 4>(P, Y, R0, 512 + lane * 8); }
}
__device__ __forceinline__ void hgrn_naive(const Params& p, int job, int lane) {
    const bf16* P = (const bf16*)(p.ws + WS_PROJ); const _Float16* LF = (const _Float16*)(p.ws + WS_LF); float* OR = (float*)(p.ws + WS_T1);
    const int b = job >> 4, h = (job >> 1) & 7, vh = job & 1;
    float S[128];
#pragma unroll
    for (int k = 0; k < 128; ++k) S[k] = 0.f;
    const size_t r0 = (size_t)b * SEQ;
    const bf16* pr = P + r0 * INC + h * 128; const _Float16* lr = LF + r0 * 1024 + h * 128;
    float nv = bf2f(pr[C_VA + vh * 64 + lane]), nq0 = bf2f(pr[C_Q + lane]), nq1 = bf2f(pr[C_Q + 64 + lane]), nk0 = bf2f(pr[C_F + lane]), nk1 = bf2f(pr[C_F + 64 + lane]), nl0 = (float)lr[lane], nl1 = (float)lr[64 + lane];
    for (int t = 0; t < SEQ; ++t) {
        const float v = nv, q0 = nq0, q1 = nq1, k0 = nk0, k1 = nk1, f0 = __expf(nl0), f1 = __expf(nl1);
        if (t + 1 < SEQ) { const bf16* pn = pr + (size_t)(t + 1) * INC; const _Float16* ln = lr + (size_t)(t + 1) * 1024;
            nv = bf2f(pn[C_VA + vh * 64 + lane]); nq0 = bf2f(pn[C_Q + lane]); nq1 = bf2f(pn[C_Q + 64 + lane]); nk0 = bf2f(pn[C_F + lane]); nk1 = bf2f(pn[C_F + 64 + lane]); nl0 = (float)ln[lane]; nl1 = (float)ln[64 + lane]; }
        float o = 0.f;
#pragma unroll
        for (int k = 0; k < 64; ++k) {
            const float fk = __int_as_float(__builtin_amdgcn_readlane(__float_as_int(f0), k)), kk = __int_as_float(__builtin_amdgcn_readlane(__float_as_int(k0), k)), qk = __int_as_float(__builtin_amdgcn_readlane(__float_as_int(q0), k));
            S[k] = fmaf(fk, S[k], kk * v); o = fmaf(S[k], qk, o); if ((k & 7) == 7) __builtin_amdgcn_sched_barrier(0); }
#pragma unroll
        for (int k = 0; k < 64; ++k) {
            const float fk = __int_as_float(__builtin_amdgcn_readlane(__float_as_int(f1), k)), kk = __int_as_float(__builtin_amdgcn_readlane(__float_as_int(k1), k)), qk = __int_as_float(__builtin_amdgcn_readlane(__float_as_int(q1), k));
            S[64 + k] = fmaf(fk, S[64 + k], kk * v); o = fmaf(S[64 + k], qk, o); if ((k & 7) == 7) __builtin_amdgcn_sched_barrier(0); }
        OR[(r0 + t) * 1024 + h * 128 + vh * 64 + lane] = o;
    }
}
__device__ __forceinline__ void ya_pass(const Params& p, int l, int wave, int lane, int G, int bidx) {
    const bf16* P = (const bf16*)(p.ws + WS_PROJ); const float* OR = (const float*)(p.ws + WS_T1); bf16* Y = (bf16*)(p.ws + WS_Y);
    const int gw = bidx * NWAVES + wave, NGW = G * NWAVES;
    for (int r = gw; r < T; r += NGW) {
#pragma unroll
        for (int h = 0; h < 8; ++h) { const int c = h * 128 + lane * 2;
            const float o0 = OR[(size_t)r * 1024 + c], o1 = OR[(size_t)r * 1024 + c + 1];
            const float rinv = rsqrtf(wave_sum(o0 * o0 + o1 * o1, lane) * (1.0f / 128.0f) + EPS);
            const unsigned z = *(const unsigned*)(P + (size_t)r * INC + C_ZA + c);
            const float g0 = p.hgrn_norm[l * 1024 + c], g1 = p.hgrn_norm[l * 1024 + c + 1];
            *(unsigned*)(Y + (size_t)r * DM + c) = pk2((o0 * rinv) * g0 * bf2f(z & 0xffffu), (o1 * rinv) * g1 * bf2f(z >> 16)); }
    }
}

#ifndef PHMASK
#define PHMASK 0xff
#endif
#define PHON(n) (((PHMASK) >> (n)) & 1)
#ifndef FOLD
#define FOLD 1
#endif
#ifndef HGRN_NAIVE
#define HGRN_NAIVE 0
#endif
typedef short bf16x8 __attribute__((ext_vector_type(8)));
constexpr int L_QT = 0, L_KH = 17408, L_KT = 34816, L_VT = 53248, L_ST = 71680, L_P = 106496, L_SEG = 115712, L_D = 119808, L_SS = 120320;
template <bool FULL>
__device__ __forceinline__ void hgrn_chunks(const Params& p, LAS unsigned char* lds, int l, int item, int tid, int wave, int lane) {
    const bf16* P = (const bf16*)(p.ws + WS_PROJ); const unsigned short* LF = (const unsigned short*)(p.ws + WS_LF); float* Gbuf = (float*)(p.ws + WS_G); float* Dt = (float*)(p.ws + WS_DT); const float* Sin = (const float*)(p.ws + WS_S); bf16* Y = (bf16*)(p.ws + WS_Y);
    const int sc = item & 15, h = (item >> 4) & 7, b = item >> 7;
    if (!FULL && sc == 15) return;
    const int cp = lane, seg = wave;
    const int fr = lane & 15, fq = lane >> 4;
    f32x4 S[8];
#pragma unroll
    for (int vt = 0; vt < 8; ++vt) S[vt] = (f32x4){0.f, 0.f, 0.f, 0.f};
    if (FULL && sc > 0) {
#pragma unroll
        for (int vt = 0; vt < 8; ++vt) S[vt] = *(const f32x4*)(Sin + (size_t)item * 16384 + (unsigned)(vt * 2048 + tid * 4));
    }
    float tot0 = 0.f, tot1 = 0.f;
    const size_t rowsc = (size_t)b * SEQ + (size_t)sc * 512;
    constexpr int PF = 2;
    unsigned lfr[PF][8], kwr[PF][8], vwr[PF][8], qwr[PF][8];
#define HG_LOAD(cc, st) do { const size_t rb_ = rowsc + (size_t)(cc) * 64 + seg * 8; _Pragma("unroll") for (int i = 0; i < 8; ++i) { \
            lfr[st][i] = *(const unsigned*)(LF + (rb_ + i) * 1024 + h * 128 + 2 * cp); \
            const bf16* pr = P + (rb_ + i) * INC + h * 128 + 2 * cp; \
            kwr[st][i] = *(const unsigned*)(pr + C_F); vwr[st][i] = *(const unsigned*)(pr + C_VA); if (FULL) qwr[st][i] = *(const unsigned*)(pr + C_Q); } \
        } while (0)
    HG_LOAD(0, 0);
    if (PF == 2) HG_LOAD(1, 1);
    for (int c2 = 0; c2 < 8; c2 += PF) {
#pragma unroll
    for (int u = 0; u < PF; ++u) { const int c = c2 + u;
        int lz = lane; asm volatile("" : "+v"(lz));
        const int cp = lz, fr = lz & 15, fq = lz >> 4;
        const size_t row0 = rowsc + c * 64;
        float b0[8], b1[8]; unsigned kw[8], vw[8], qw[8];
#pragma unroll
        for (int i = 0; i < 8; ++i) { const f16x2 f2 = __builtin_bit_cast(f16x2, lfr[u][i]); b0[i] = (float)f2.x; b1[i] = (float)f2.y; kw[i] = kwr[u][i]; vw[i] = vwr[u][i]; if (FULL) qw[i] = qwr[u][i]; }
#pragma unroll
        for (int i = 1; i < 8; ++i) { b0[i] += b0[i - 1]; b1[i] += b1[i - 1]; }
        *(LAS f32x2*)(lds + L_SEG + (seg * 128 + 2 * cp) * 4) = (f32x2){b0[7], b1[7]};
        __syncthreads();
        float off0 = 0.f, off1 = 0.f, mid0 = 0.f, mid1 = 0.f, t0 = 0.f, t1 = 0.f;
#pragma unroll
        for (int s = 0; s < 8; ++s) { const f32x2 st = *(const LAS f32x2*)(lds + L_SEG + (s * 128 + 2 * cp) * 4);
            if (s == seg) { off0 = t0; off1 = t1; } if (s == 4) { mid0 = t0; mid1 = t1; } t0 += st.x; t1 += st.y; }
        tot0 += t0; tot1 += t1;
        {
            unsigned kt0[4], kt1[4], vt0[4], vt1[4];
#pragma unroll
            for (int i = 0; i < 8; i += 2) {
                float k0[2], k1[2], v0[2], v1[2];
#pragma unroll
                for (int u = 0; u < 2; ++u) { const int ii = i + u; const float bt0 = off0 + b0[ii], bt1 = off1 + b1[ii];
                    const float kk0 = bf2f(kw[ii] & 0xffffu), kk1 = bf2f(kw[ii] >> 16);
                    k0[u] = kk0 * __expf(t0 - bt0); k1[u] = kk1 * __expf(t1 - bt1); v0[u] = bf2f(vw[ii] & 0xffffu); v1[u] = bf2f(vw[ii] >> 16);
                    if (FULL) { const float e0 = __expf(bt0 - mid0), e1 = __expf(bt1 - mid1), r0 = __expf(mid0 - bt0), r1 = __expf(mid1 - bt1);
                        *(LAS unsigned*)(lds + L_QT + (seg * 8 + ii) * 272 + cp * 4) = pk2(bf2f(qw[ii] & 0xffffu) * e0, bf2f(qw[ii] >> 16) * e1);
                        *(LAS unsigned*)(lds + L_KH + (seg * 8 + ii) * 272 + cp * 4) = pk2(kk0 * r0, kk1 * r1); } }
                kt0[i >> 1] = pk2(k0[0], k0[1]); kt1[i >> 1] = pk2(k1[0], k1[1]); vt0[i >> 1] = pk2(v0[0], v0[1]); vt1[i >> 1] = pk2(v1[0], v1[1]); }
            *(LAS v4u*)(lds + L_KT + (2 * cp) * 144 + seg * 16) = (v4u){kt0[0], kt0[1], kt0[2], kt0[3]};
            *(LAS v4u*)(lds + L_KT + (2 * cp + 1) * 144 + seg * 16) = (v4u){kt1[0], kt1[1], kt1[2], kt1[3]};
            *(LAS v4u*)(lds + L_VT + (2 * cp) * 144 + seg * 16) = (v4u){vt0[0], vt0[1], vt0[2], vt0[3]};
            *(LAS v4u*)(lds + L_VT + (2 * cp + 1) * 144 + seg * 16) = (v4u){vt1[0], vt1[1], vt1[2], vt1[3]};
            if (seg == 0) *(LAS f32x2*)(lds + L_D + 2 * cp * 4) = (f32x2){__expf(t0), __expf(t1)};
        }
        if (c + PF < 8) HG_LOAD(c + PF, u);
        if (FULL) {
            f32x4 m4 = {0.f, 0.f, 0.f, 0.f};
#pragma unroll
            for (int s = 0; s < 4; ++s) m4 += *(const LAS f32x4*)(lds + L_SEG + (s * 128 + 16 * wave + fq * 4) * 4);
            const f32x4 er = {__expf(m4[0]), __expf(m4[1]), __expf(m4[2]), __expf(m4[3])};
#pragma unroll
            for (int vt = 0; vt < 8; ++vt) { const f32x4 sv = S[vt] * er;
                *(LAS v2u*)(lds + L_ST + (16 * vt + fr) * 272 + (16 * wave + fq * 4) * 2) = (v2u){pk2(sv[0], sv[1]), pk2(sv[2], sv[3])}; }
        }
        __syncthreads();
        if (FULL) {
            const int tt = wave >> 1, wh = wave & 1;
            v2u zc[4];
#pragma unroll
            for (int j = 0; j < 4; ++j) zc[j] = *(const v2u*)(P + (row0 + 8 * wave + 2 * j + (lz >> 5)) * INC + C_ZA + h * 128 + (lz & 31) * 4);
            bf16x8 Qf[4];
#pragma unroll
            for (int ks = 0; ks < 4; ++ks) Qf[ks] = *(const LAS bf16x8*)(lds + L_QT + (16 * tt + fr) * 272 + (ks * 32 + fq * 8) * 2);
            {
                bf16x8 Kf[2][4]; f32x4 a2[2] = {{0.f, 0.f, 0.f, 0.f}, {0.f, 0.f, 0.f, 0.f}};
#pragma unroll
                for (int s2 = 0; s2 < 2; ++s2) if (2 * wh + s2 <= tt) {
#pragma unroll
                    for (int ks = 0; ks < 4; ++ks) Kf[s2][ks] = *(const LAS bf16x8*)(lds + L_KH + (16 * (2 * wh + s2) + fr) * 272 + (ks * 32 + fq * 8) * 2); }
#pragma unroll
                for (int ks = 0; ks < 4; ++ks)
#pragma unroll
                    for (int s2 = 0; s2 < 2; ++s2) if (2 * wh + s2 <= tt) a2[s2] = __builtin_amdgcn_mfma_f32_16x16x32_bf16(Kf[s2][ks], Qf[ks], a2[s2], 0, 0, 0);
#pragma unroll
                for (int s2 = 0; s2 < 2; ++s2) { const int st = 2 * wh + s2; f32x4 a = a2[s2];
                    const int t = 16 * tt + fr, s0 = 16 * st + fq * 4;
#pragma unroll
                    for (int r = 0; r < 4; ++r) a[r] = (st <= tt && s0 + r <= t) ? a[r] : 0.f;
                    *(LAS v2u*)(lds + L_P + (16 * tt + fr) * 144 + (16 * st + fq * 4) * 2) = (v2u){pk2(a[0], a[1]), pk2(a[2], a[3])}; }
            }
            __syncthreads();
            f32x4 O[4] = {{0.f, 0.f, 0.f, 0.f}, {0.f, 0.f, 0.f, 0.f}, {0.f, 0.f, 0.f, 0.f}, {0.f, 0.f, 0.f, 0.f}};
#pragma unroll
            for (int kh = 0; kh < 2; ++kh) {
                bf16x8 sf[2][4];
#pragma unroll
                for (int k1 = 0; k1 < 2; ++k1)
#pragma unroll
                    for (int j = 0; j < 4; ++j) sf[k1][j] = *(const LAS bf16x8*)(lds + L_ST + (16 * (4 * wh + j) + fr) * 272 + ((2 * kh + k1) * 32 + fq * 8) * 2);
#pragma unroll
                for (int k1 = 0; k1 < 2; ++k1)
#pragma unroll
                    for (int j = 0; j < 4; ++j) O[j] = __builtin_amdgcn_mfma_f32_16x16x32_bf16(sf[k1][j], Qf[2 * kh + k1], O[j], 0, 0, 0); }
            {
                bf16x8 pf[2], vf[2][4];
#pragma unroll
                for (int k2 = 0; k2 < 2; ++k2) { pf[k2] = *(const LAS bf16x8*)(lds + L_P + (16 * tt + fr) * 144 + (k2 * 32 + fq * 8) * 2);
#pragma unroll
                    for (int j = 0; j < 4; ++j) vf[k2][j] = *(const LAS bf16x8*)(lds + L_VT + (16 * (4 * wh + j) + fr) * 144 + (k2 * 32 + fq * 8) * 2); }
#pragma unroll
                for (int k2 = 0; k2 < 2; ++k2)
#pragma unroll
                    for (int j = 0; j < 4; ++j) O[j] = __builtin_amdgcn_mfma_f32_16x16x32_bf16(vf[k2][j], pf[k2], O[j], 0, 0, 0); }
            float ss = 0.f;
#pragma unroll
            for (int j = 0; j < 4; ++j) ss += (O[j][0] * O[j][0] + O[j][1] * O[j][1]) + (O[j][2] * O[j][2] + O[j][3] * O[j][3]);
            ss += xshfl(ss, 16, lz); ss += xshfl(ss, 32, lz);
            if (fq == 0) *(LAS float*)(lds + L_SS + ((16 * tt + fr) * 2 + wh) * 4) = ss;
            __syncthreads();
            const f32x2 s2 = *(const LAS f32x2*)(lds + L_SS + (16 * tt + fr) * 8);
            const float rinv = rsqrtf((s2.x + s2.y) * (1.0f / 128.0f) + EPS);
#pragma unroll
            for (int j = 0; j < 4; ++j) *(LAS f32x4*)(lds + L_QT + (16 * tt + fr) * 528 + (16 * (4 * wh + j) + fq * 4) * 4) = O[j] * rinv;
            __syncthreads();
#pragma unroll
            for (int j = 0; j < 4; ++j) { const int r = 8 * wave + 2 * j + (lz >> 5), c4 = (lz & 31) * 4;
                const f32x4 y = *(const LAS f32x4*)(lds + L_QT + r * 528 + c4 * 4); const v2u z = zc[j];
                *(v2u*)(Y + (row0 + r) * DM + h * 128 + c4) = (v2u){pk2(y[0] * bf2f(z.x & 0xffffu), y[1] * bf2f(z.x >> 16)), pk2(y[2] * bf2f(z.y & 0xffffu), y[3] * bf2f(z.y >> 16))}; }
        }
        {
            const f32x4 dv = *(const LAS f32x4*)(lds + L_D + (16 * wave + fq * 4) * 4);
#pragma unroll
            for (int vt = 0; vt < 8; ++vt) S[vt] = S[vt] * dv;
#pragma unroll
            for (int k2 = 0; k2 < 2; ++k2) { bf16x8 vf[8];
                const bf16x8 af = *(const LAS bf16x8*)(lds + L_KT + (16 * wave + fr) * 144 + (k2 * 32 + fq * 8) * 2);
#pragma unroll
                for (int vt = 0; vt < 8; ++vt) vf[vt] = *(const LAS bf16x8*)(lds + L_VT + (16 * vt + fr) * 144 + (k2 * 32 + fq * 8) * 2);
#pragma unroll
                for (int vt = 0; vt < 8; ++vt) S[vt] = __builtin_amdgcn_mfma_f32_16x16x32_bf16(af, vf[vt], S[vt], 0, 0, 0); }
        }
    }
    }
#undef HG_LOAD
    if (!FULL) {
#pragma unroll
        for (int vt = 0; vt < 8; ++vt) *(f32x4*)(Gbuf + (size_t)item * 16384 + (unsigned)(vt * 2048 + tid * 4)) = S[vt];
        if (seg == 0) *(f32x2*)(Dt + (size_t)item * 128 + 2 * cp) = (f32x2){__expf(tot0), __expf(tot1)};
    }
    __syncthreads();
}
#define RLX_AGENT __ATOMIC_RELAXED, __HIP_MEMORY_SCOPE_AGENT
#define XB_TMO      128
#define XB_XCNT(j)  (256  + 64 * (j))
#define XB_XSUB(j)  (1280 + 64 * (j))
#define XB_XGEN(j)  (2304 + 64 * (j))
#define XB_TOP      3328
#define XB_TOPGEN   3392
#define XCD_BAR_WORDS 3456
#define XB_SPIN_CAP (1u << 18)

__device__ __forceinline__ unsigned xb_ld(unsigned* p)              { return __hip_atomic_load(p, __ATOMIC_RELAXED, __HIP_MEMORY_SCOPE_AGENT); }
__device__ __forceinline__ unsigned xb_add(unsigned* p, unsigned v) { return __hip_atomic_fetch_add(p, v, __ATOMIC_RELAXED, __HIP_MEMORY_SCOPE_AGENT); }
__device__ __forceinline__ unsigned xb_xcc_id() { return (unsigned)__builtin_amdgcn_s_getreg((3 << 11) | 20) & 0xFu; }
#define XB_SPIN(cond, bar) do { unsigned _sp = 0; while (cond) { __builtin_amdgcn_s_sleep(1); \
    if ((++_sp & 255u) == 0u) { if (xb_ld(&(bar)[XB_TMO])) break; if (_sp > XB_SPIN_CAP) { atomicAdd(&(bar)[XB_TMO], 1u); break; } } } } while (0)

struct XcdBarrier {
    unsigned* bar; unsigned x;
    volatile LAS unsigned* st;
};

__device__ __forceinline__ XcdBarrier xcd_barrier_post(unsigned* bar, volatile LAS unsigned* st) {
    XcdBarrier b; b.bar = bar; b.x = xb_xcc_id(); b.st = st;
    if (threadIdx.x == 0) (void)xb_add(&bar[XB_XCNT(b.x)], 1u);
    return b;
}
__device__ __forceinline__ void xcd_barrier_complete(unsigned* bar, unsigned x, unsigned& nloc, unsigned& nx) {
    const unsigned G = gridDim.x * gridDim.y * gridDim.z;
    unsigned sum, cnt, mine, sp = 0u;
    for (;;) {
        sum = 0u; cnt = 0u; mine = 0u;
#pragma unroll
        for (unsigned j = 0; j < 16; ++j) { const unsigned c = xb_ld(&bar[XB_XCNT(j)]); sum += c; cnt += (c > 0u) ? 1u : 0u; mine = (j == x) ? c : mine; }
        if (sum == G) break;
        __builtin_amdgcn_s_sleep(1);
        if ((++sp & 255u) == 0u) { if (xb_ld(&bar[XB_TMO])) break; if (sp > XB_SPIN_CAP) { atomicAdd(&bar[XB_TMO], 1u); break; } }
    }
    nloc = mine > 0u ? mine : 1u; nx = cnt > 0u ? cnt : 1u;
}

__device__ __forceinline__ void xcd_barrier(const XcdBarrier& b, bool is_t0) {
    asm volatile("s_waitcnt vmcnt(0)" ::: "memory");
    __syncthreads();
    if (is_t0) {
        unsigned* bar = b.bar;
        __builtin_amdgcn_s_waitcnt(0);
        unsigned nloc = b.st[0], nx = b.st[1];
        if (nloc == 0u) { xcd_barrier_complete(bar, b.x, nloc, nx); b.st[0] = nloc; b.st[1] = nx; }
        const unsigned old = xb_add(&bar[XB_XSUB(b.x)], 1u);
        const unsigned gen = old / nloc;
        if (old + 1u == (gen + 1u) * nloc) {
            __builtin_amdgcn_fence(__ATOMIC_RELEASE, "agent");
            asm volatile("s_waitcnt vmcnt(0)" ::: "memory");
            const unsigned og = xb_add(&bar[XB_TOP], 1u);
            const unsigned tg = og / nx;
            if (og + 1u == (tg + 1u) * nx) xb_add(&bar[XB_TOPGEN], 1u);
            else XB_SPIN(xb_ld(&bar[XB_TOPGEN]) == tg, bar);
            __builtin_amdgcn_fence(__ATOMIC_ACQUIRE, "agent");
            xb_add(&bar[XB_XGEN(b.x)], 1u);
            asm volatile("s_waitcnt vmcnt(0)" ::: "memory");
        } else {
            XB_SPIN(xb_ld(&bar[XB_XGEN(b.x)]) == gen, bar);
            __builtin_amdgcn_fence(__ATOMIC_ACQUIRE, "agent");
            asm volatile("s_waitcnt vmcnt(0)" ::: "memory");
        }
    }
    __syncthreads();
}

__device__ __forceinline__ void hgrn_scan(const Params& p, int tid, int bidx) {
    const float* Gbuf = (const float*)(p.ws + WS_G); const float* Dt = (const float*)(p.ws + WS_DT); float* Sin = (float*)(p.ws + WS_S);
    const int u = bidx * (NWAVES * 64) + tid;
    if (u >= 16 * 4096) return;
    const int bh = u >> 12, e4 = u & 4095, t_ = e4 & 511, k0 = 16 * (t_ >> 6) + ((t_ & 63) >> 4) * 4;
    f32x4 g[15], d[15];
#pragma unroll
    for (int sc = 0; sc < 15; ++sc) { g[sc] = *(const f32x4*)(Gbuf + (size_t)(bh * 16 + sc) * 16384 + (size_t)e4 * 4); d[sc] = *(const f32x4*)(Dt + (size_t)(bh * 16 + sc) * 128 + k0); }
    f32x4 S = {0.f, 0.f, 0.f, 0.f};
#pragma unroll
    for (int sc = 0; sc < 15; ++sc) { S = d[sc] * S + g[sc]; *(f32x4*)(Sin + (size_t)(bh * 16 + sc + 1) * 16384 + (size_t)e4 * 4) = S; }
}
constexpr int LDS_PARAM_OFF = 163840 - 1024;
__device__ __forceinline__ void load_params(Params& q, LAS unsigned char* lds) {
    unsigned pbase = LDS_PARAM_OFF; asm volatile("" : "+v"(pbase));
    volatile LAS unsigned long long* s = (volatile LAS unsigned long long*)(lds + pbase);
    unsigned long long v[16];
#pragma unroll
    for (int i = 0; i < 16; ++i) { const unsigned long long w = s[i]; v[i] = ((unsigned long long)(unsigned)__builtin_amdgcn_readfirstlane((int)(unsigned)(w >> 32)) << 32) | (unsigned)__builtin_amdgcn_readfirstlane((int)(unsigned)w); }
    q.x = (const float*)(const GAS float*)v[0]; q.c = (const float*)(const GAS float*)v[1]; q.w_ada = (const float*)(const GAS float*)v[2]; q.b_ada = (const float*)(const GAS float*)v[3]; q.norm_pre = (const float*)(const GAS float*)v[4]; q.norm_post = (const float*)(const GAS float*)v[5];
    q.w_in = (const float*)(const GAS float*)v[6]; q.lower_bounds = (const float*)(const GAS float*)v[7]; q.hgrn_norm = (const float*)(const GAS float*)v[8]; q.pool_w = (const float*)(const GAS float*)v[9]; q.pool_scale = (const float*)(const GAS float*)v[10];
    q.w_proj_a = (const float*)(const GAS float*)v[11]; q.w_proj_b = (const float*)(const GAS float*)v[12]; q.w_out = (const float*)(const GAS float*)v[13]; q.out = (float*)(GAS float*)v[14]; q.ws = (unsigned char*)(GAS unsigned char*)v[15];
}
#ifndef PROBE_SET
#define PROBE_SET 0
#endif
#ifndef DUP
#define DUP 0
#endif
#ifndef PROBE_A
#define PROBE_A 3
#endif
#ifndef PROBE_B
#define PROBE_B 4
#endif
#define SLOT(id) ((id) == PROBE_A ? 0 : (id) == PROBE_B ? 1 : -1)
#define TSTAMP(slot) do { if (PROBE_SET) { if (tid == 0) { volatile LAS unsigned long long* tw = (volatile LAS unsigned long long*)(lds + LDS_PARAM_OFF + 256); const unsigned long long now = __builtin_amdgcn_s_memrealtime(); if ((slot) >= 0) tw[(slot)] += now - tw[2]; tw[2] = now; } } } while (0)
#define LOADP(q) Params q; load_params(q, lds); unsigned char* ws = q.ws; (void)ws; int Gp = G, bx = (int)blockIdx.x, wv = wave; asm volatile("" : "+s"(Gp), "+s"(bx), "+s"(wv)); int ln = (int)__builtin_amdgcn_mbcnt_hi(~0u, __builtin_amdgcn_mbcnt_lo(~0u, 0u)); asm volatile("" : "+v"(ln)); const int td = wv * 64 + ln; (void)Gp; (void)bx; (void)wv; (void)ln; (void)td
__global__ void __launch_bounds__(NWAVES * 64, 2) trunk_fwd(Params p) {
    extern __shared__ __attribute__((aligned(16))) unsigned char lds_raw[];
    cg::grid_group grid = cg::this_grid();
#define XSYNC1() do { LOADP(qb); XcdBarrier xb_; xb_.bar = (unsigned*)(ws + WS_BAR); xb_.x = xb_xcc_id(); xb_.st = (volatile LAS unsigned*)(lds + LDS_PARAM_OFF + 512); xcd_barrier(xb_, td == 0); } while (0)
#define GSYNC() do { XSYNC1(); if ((DUP >> 5) & 1) XSYNC1(); } while (0)
    LAS unsigned char* lds = (LAS unsigned char*)lds_raw;
    const int tid = threadIdx.x, lane = tid & 63, wave = __builtin_amdgcn_readfirstlane(tid >> 6), G = gridDim.x;
    if (tid == 0) { volatile LAS unsigned long long* s = (volatile LAS unsigned long long*)(lds + LDS_PARAM_OFF);
        s[0] = (unsigned long long)p.x; s[1] = (unsigned long long)p.c; s[2] = (unsigned long long)p.w_ada; s[3] = (unsigned long long)p.b_ada; s[4] = (unsigned long long)p.norm_pre; s[5] = (unsigned long long)p.norm_post;
        s[6] = (unsigned long long)p.w_in; s[7] = (unsigned long long)p.lower_bounds; s[8] = (unsigned long long)p.hgrn_norm; s[9] = (unsigned long long)p.pool_w; s[10] = (unsigned long long)p.pool_scale;
        s[11] = (unsigned long long)p.w_proj_a; s[12] = (unsigned long long)p.w_proj_b; s[13] = (unsigned long long)p.w_out; s[14] = (unsigned long long)p.out; s[15] = (unsigned long long)p.ws; }
    if (tid == 0) { volatile LAS unsigned* st = (volatile LAS unsigned*)(lds + LDS_PARAM_OFF + 512); st[0] = 0u; st[1] = 0u; }
    if (PROBE_SET && tid == 0) { volatile LAS unsigned long long* tw = (volatile LAS unsigned long long*)(lds + LDS_PARAM_OFF + 256); tw[0] = 0; tw[1] = 0; tw[2] = 0; }
    __syncthreads();
    TSTAMP(-1);

    for (int rep = 0; rep < 1 + (DUP & 1); ++rep) { LOADP(q); phase0(q, lds, td, wv, ln, Gp, bx); __syncthreads(); }
    { LOADP(q); if (bx == 0) for (int i = td; i < XCD_BAR_WORDS; i += NWAVES * 64) __hip_atomic_store((unsigned*)(ws + WS_BAR) + i, 0u, RLX_AGENT); }
    grid.sync();
    { LOADP(q); (void)xcd_barrier_post((unsigned*)(ws + WS_BAR), (volatile LAS unsigned*)(lds + LDS_PARAM_OFF + 512)); }
    { LOADP(q); phase_mod(q, td, Gp, bx); }
#if FOLD
    {
        LOADP(q);
        pg8::Gemm g{(const bf16*)(ws + WS_WVB), (const bf16*)(ws + WS_WPOOL), DM, 4096, 256, 4096, 256, 256, 0}; pg8::StaticOrder S; S.init(DM, 4096, Gp, bx);
        EpiFold E{(bf16*)(ws + WS_WIN), q.pool_scale};
        pg8::gemm_phase<EpiFold, pg8::StaticOrder, true, true>(lds, g, S, E, td);
    }
#endif
    GSYNC();
    TSTAMP(SLOT(0));
    for (int l = 0; l < DEPTH; ++l) {
        for (int rep = 0; rep < 1 + (((DUP >> 2) & 1) && l <= 1); ++rep) { LOADP(q); if (l == 0) row_pass<0>(q, lds, l, td, wv, ln, Gp, bx); else if (l == 1) row_pass<1>(q, lds, l, td, wv, ln, Gp, bx); else row_pass<2>(q, lds, l, td, wv, ln, Gp, bx); }
        GSYNC();
        TSTAMP(SLOT(1));
        if ((DUP >> 6) & 1) {
            LOADP(q);
            pg8::Gemm g{(const bf16*)(ws + WS_H), (const bf16*)(ws + WS_WIN) + (size_t)l * INC * LDH, T, INC, DM, LDH, LDH, 0, 0}; pg8::StaticOrder S; S.init(T, INC, Gp, bx);
            EpiGen<0> E{(bf16*)(ws + WS_PROJ), INC, nullptr, 0, nullptr, 0, nullptr};
            pg8::gemm_phase<EpiGen<0>, pg8::StaticOrder, true, true>(lds, g, S, E, td);
            GSYNC();
        }
        for (int rep = 0; rep < 1 + ((DUP >> 3) & 1); ++rep) {
            LOADP(q);
            pg8::Gemm g{(const bf16*)(ws + WS_H), (const bf16*)(ws + WS_WIN) + (size_t)l * INC * LDH, T, INC, DM, LDH, LDH, 0, 0}; pg8::StaticOrder S; S.init(T, INC, Gp, bx);
            EpiProj E{(bf16*)(ws + WS_PROJ), (unsigned short*)(ws + WS_LF), (const float*)(ws + WS_LB) + l * 1024, (v4u*)(ws + WS_GT)};
            pg8::gemm_phase<EpiProj, pg8::StaticOrder, true, true>(lds, g, S, E, td);
        }
        GSYNC();
        TSTAMP(SLOT(2));
#if HGRN_NAIVE
        { LOADP(q);
          if (bx < 32) { if (wv == 0) hgrn_naive(q, bx, ln); }
          else pooled_pass(q, wv, ln, Gp - 32, bx - 32); }
        GSYNC();
        { LOADP(q); ya_pass(q, l, wv, ln, Gp, bx); }
#else
        for (int rep = 0; rep < 1 + ((DUP >> 1) & 1); ++rep) {
        if (rep) GSYNC();
        { LOADP(q); for (int rep = 0; rep < 1 + ((DUP >> 8) & 1); ++rep) for (int item = bx; item < 256; item += Gp) hgrn_chunks<false>(q, lds, l, item, td, wv, ln);
          for (int rep = 0; rep < 1 + ((DUP >> 7) & 1); ++rep) { if (FOLD) yb_pass(q, l, wv, ln, Gp, bx); else pooled_pass(q, wv, ln, Gp, bx); } }
        GSYNC();
        { LOADP(q); hgrn_scan(q, td, bx); }
        GSYNC();
        TSTAMP(SLOT(3));
        { LOADP(q); for (int rep = 0; rep < 1 + ((DUP >> 9) & 1); ++rep) for (int item = bx; item < 256; item += Gp) hgrn_chunks<true>(q, lds, l, item, td, wv, ln); }
        }
        TSTAMP(SLOT(4));
#endif
        for (int rep = 0; rep < (FOLD ? 0 : 1 + ((DUP >> 10) & 1)); ++rep) {
            LOADP(q);
            pg8::Gemm g{(const bf16*)(ws + WS_POOLED), (const bf16*)(ws + WS_WPOOL) + (size_t)l * 1024 * 256, T, 1024, 256, 1024, 256, 256, 0}; pg8::StaticOrder S; S.init(T, 1024, Gp, bx);
            EpiGen<1> E{(bf16*)(ws + WS_Y) + 1024, DM, nullptr, 0, (const bf16*)(ws + WS_PROJ) + C_ZB, INC, q.pool_scale + l * 1024};
            pg8::gemm_phase<EpiGen<1>, pg8::StaticOrder, true, true>(lds, g, S, E, td);
        }
        GSYNC();
        TSTAMP(SLOT(5));
        for (int rep = 0; rep < 1 + ((DUP >> 4) & 1); ++rep) {
        if (rep) GSYNC();
        {
            LOADP(q);
            pg8::Gemm g{(const bf16*)(ws + WS_Y), (const bf16*)(ws + WS_WPA) + (size_t)l * 4096 * 1024, T, 2 * DM, 1024, DM, 1024, 1024, 3}; PairOrder S; S.init(T, DM, Gp, bx);
            EpiPair E{(bf16*)(ws + WS_MERGED), (const v4u*)(ws + WS_GT)};
            pg8::gemm_phase<EpiPair, PairOrder, true, true>(lds, g, S, E, td);
        }
        GSYNC();
        TSTAMP(SLOT(6));
        if (PHON(4)) {
            LOADP(q);
            pg8::Gemm g{(const bf16*)(ws + WS_MERGED), (const bf16*)(ws + WS_WOUT) + (size_t)l * DM * DM, T, DM, DM, DM, DM, 0, 0}; pg8::StaticOrder S; S.init(T, DM, Gp, bx);
            EpiGen<0> E{(bf16*)(ws + WS_OUT), DM, nullptr, 0, nullptr, 0, nullptr};
            pg8::gemm_phase<EpiGen<0>, pg8::StaticOrder, true, true>(lds, g, S, E, td);
        }
        }
        GSYNC();
        TSTAMP(SLOT(7));
    }
    { LOADP(q); row_pass<3>(q, lds, DEPTH, td, wv, ln, Gp, bx); }
#if PROBE_SET
    GSYNC();
    TSTAMP(SLOT(1));
    __syncthreads();
    if (blockIdx.x == 0) { LOADP(q); volatile LAS unsigned long long* tw = (volatile LAS unsigned long long*)(lds + LDS_PARAM_OFF + 256);
        const float ta = (float)tw[0] * 0.01f, tb = (float)tw[1] * 0.01f;
        for (int i = td; i < 512 * DM; i += NWAVES * 64) q.out[i] *= 1.0f + tb * (1.0f / 300.0f);
        __syncthreads();
        if (td == 0) q.out[0] += ta * 0.25f; }
#endif
}

extern "C" void kernel_launch(void* const* d_in, const int* in_sizes, int n_in, void* d_out, int out_size, void* d_ws, size_t ws_size, hipStream_t stream) {
    static int grid_blocks = 0;
    if (!grid_blocks) {
        if (n_in != 14 || out_size != T * DM || ws_size < WS_END) { fprintf(stderr, "kernel_launch: unexpected shapes (n_in %d out %d ws %zu, need %zu)\n", n_in, out_size, ws_size, (size_t)WS_END); grid_blocks = -1; return; }
        int dev = 0, cus = 0, per_cu = 0;
        hipGetDevice(&dev);
        hipDeviceGetAttribute(&cus, hipDeviceAttributeMultiprocessorCount, dev);
        if (hipFuncSetAttribute((const void*)trunk_fwd, hipFuncAttributeMaxDynamicSharedMemorySize, LDS_BYTES) != hipSuccess) fprintf(stderr, "kernel_launch: hipFuncSetAttribute failed\n");
        hipOccupancyMaxActiveBlocksPerMultiprocessor(&per_cu, trunk_fwd, NWAVES * 64, LDS_BYTES);
        if (per_cu < 1) per_cu = 1;
        grid_blocks = cus * 1;
        fprintf(stderr, "kernel_launch: cus %d per_cu %d grid %d\n", cus, per_cu, grid_blocks);
    }
    if (grid_blocks <= 0) return;
    Params p{};
    p.x = (const float*)d_in[0]; p.c = (const float*)d_in[1]; p.w_ada = (const float*)d_in[2]; p.b_ada = (const float*)d_in[3]; p.norm_pre = (const float*)d_in[4]; p.norm_post = (const float*)d_in[5];
    p.w_in = (const float*)d_in[6]; p.lower_bounds = (const float*)d_in[7]; p.hgrn_norm = (const float*)d_in[8]; p.pool_w = (const float*)d_in[9]; p.pool_scale = (const float*)d_in[10];
    p.w_proj_a = (const float*)d_in[11]; p.w_proj_b = (const float*)d_in[12]; p.w_out = (const float*)d_in[13];
    p.out = (float*)d_out; p.ws = (unsigned char*)d_ws;
    void* args[] = {&p};
    hipError_t e = hipLaunchCooperativeKernel((const void*)trunk_fwd, dim3(grid_blocks), dim3(NWAVES * 64), args, LDS_BYTES, stream);
    if (e != hipSuccess) fprintf(stderr, "kernel_launch: cooperative launch failed: %s (grid %d)\n", hipGetErrorString(e), grid_blocks);
}
```
